# Optimizing an MI355X kernel written in HIP

```python
import math
import jax
import jax.numpy as jnp
from jax import lax
import numpy as np

D_MODEL = 1024
BATCH = 4
SEQ = 8192
DEPTH = 1

GRID_W = 64
CTX_LEN = 256
D_MIX = D_MODEL
D_HYENA = D_MIX // 2
HYENA_SHORT_W = 3
FILTER_ORDER = 64
POS_EMB_DIM = 33
DECAY_TARGET = 1e-2
FAST_DECAY_PCT = 0.3
SLOW_DECAY_PCT = 1.5
MIN_DECAY = math.log(DECAY_TARGET) / FAST_DECAY_PCT
MAX_DECAY = math.log(DECAY_TARGET) / SLOW_DECAY_PCT
NOPE_DIM = 128
ROPE_DIM = 64
QK_DIM = NOPE_DIM + ROPE_DIM
V_DIM = 128
MLA_HEADS = (D_MIX - D_HYENA) // V_DIM
Q_RANK = 256
KV_RANK = 128
ROPE_THETA = 10000.0
Q_BLOCK = 128
N_EXPERTS = 32
TOP_K = 4
D_FF = D_MODEL
SWIGLU_ALPHA = 1.702
SWIGLU_LIMIT = 7.0
MOE_BLOCK = 128
NORM_EPS = 1e-6
HY_COLS = 3 * D_HYENA
KV_COL = HY_COLS + Q_RANK
PE_COL = KV_COL + KV_RANK
IN_COLS = PE_COL + ROPE_DIM

kernel_name = "hyena_mla_moe_hybrid_dit_layer"


def rms_norm(x, g):
    xf = x.astype(jnp.float32)
    y = xf * lax.rsqrt(jnp.mean(xf * xf, axis=-1, keepdims=True) + NORM_EPS)
    return (y * g.astype(jnp.float32)).astype(x.dtype)


def modulate(h, shift, scale):
    return h * (1.0 + scale) + shift


def axial_rope_tables(L):
    rows = L // GRID_W
    row = jnp.repeat(jnp.arange(rows, dtype=jnp.int32), GRID_W).astype(jnp.float32)
    col = jnp.tile(jnp.arange(GRID_W, dtype=jnp.int32), rows).astype(jnp.float32)
    n_freq = ROPE_DIM // 4
    inv_freq = jnp.power(ROPE_THETA, -jnp.arange(n_freq, dtype=jnp.float32) / n_freq)
    ang = jnp.stack([row[:, None] * inv_freq, col[:, None] * inv_freq], axis=1)
    return jnp.cos(ang), jnp.sin(ang)


def apply_axial_rope(x, cos, sin):
    shp = x.shape
    xr = x.reshape(*shp[:-1], 2, ROPE_DIM // 2)
    x1, x2 = xr[..., : ROPE_DIM // 4], xr[..., ROPE_DIM // 4:]
    cb = cos[None, :, None].astype(x.dtype)
    sb = sin[None, :, None].astype(x.dtype)
    out = jnp.concatenate([x1 * cb - x2 * sb, x2 * cb + x1 * sb], axis=-1)
    return out.reshape(shp)


def short_conv(u, w, b):
    up = jnp.pad(u, ((0, 0), (1, 1), (0, 0)))
    return up[:, :-2] * w[0] + up[:, 1:-1] * w[1] + up[:, 2:] * w[2] + b


def hyena_filters(L, w1, b1, w2, b2, w3, b3, w4, freq):
    t = jnp.linspace(0.0, 1.0, L, dtype=jnp.float32)[:, None]
    bands = (POS_EMB_DIM - 1) // 2
    w_ang = 2.0 * math.pi * jnp.arange(L, dtype=jnp.float32)[:, None] / L
    f = jnp.linspace(1e-4, bands - 1, bands, dtype=jnp.float32)[None, :]
    z = jnp.concatenate([t, jnp.cos(f * w_ang), -jnp.sin(f * w_ang)], axis=-1)
    fr = freq.astype(jnp.float32)
    h = jnp.sin(fr * (z @ w1.astype(jnp.float32) + b1.astype(jnp.float32)))
    h = jnp.sin(fr * (h @ w2.astype(jnp.float32) + b2.astype(jnp.float32)))
    h = jnp.sin(fr * (h @ w3.astype(jnp.float32) + b3.astype(jnp.float32)))
    h = (h @ w4.astype(jnp.float32)).reshape(L, 2, D_HYENA)
    deltas = jnp.linspace(MIN_DECAY, MAX_DECAY, D_HYENA, dtype=jnp.float32)
    decay = jnp.exp(-t * jnp.abs(deltas))
    h = h * decay[:, None, :]
    h = h / jnp.sum(jnp.abs(h), axis=(0, 1), keepdims=True)
    return h[:, 0], h[:, 1]


def bidir_fft_conv(u, h_fwd, h_bwd):
    B, L, C = u.shape
    kern = jnp.concatenate([h_fwd, jnp.zeros((1, C), h_fwd.dtype), h_bwd[:0:-1]], axis=0)
    k_f = jnp.fft.rfft(kern, n=2 * L, axis=0)
    u_f = jnp.fft.rfft(u.astype(jnp.float32), n=2 * L, axis=1)
    y = jnp.fft.irfft(u_f * k_f[None], n=2 * L, axis=1)[:, :L]
    return y.astype(u.dtype)


def hyena_mixer(u, conv_w, conv_b, w1, b1, w2, b2, w3, b3, w4, freq, bias):
    L = u.shape[1]
    uc = short_conv(u, conv_w, conv_b)
    x0, x1, v = jnp.split(uc, 3, axis=-1)
    h_fwd, h_bwd = hyena_filters(L, w1, b1, w2, b2, w3, b3, w4, freq)
    v = v * x1
    v = bidir_fft_conv(v, h_fwd, h_bwd) + v * bias
    return v * x0


def mla_queries(c_q, q_norm_g, w_uq, qn_g, rope):
    B, L, _ = c_q.shape
    q = (rms_norm(c_q, q_norm_g) @ w_uq).reshape(B, L, MLA_HEADS, QK_DIM)
    q = rms_norm(q, qn_g)
    if rope is not None:
        q = jnp.concatenate([q[..., :NOPE_DIM], apply_axial_rope(q[..., NOPE_DIM:], *rope)], axis=-1)
    return q


def mla_keys_values(c_kv, k_pe, kv_norm_g, w_ukv, kn_g, rope):
    B, L, _ = c_kv.shape
    kv = (rms_norm(c_kv, kv_norm_g) @ w_ukv).reshape(B, L, MLA_HEADS, NOPE_DIM + V_DIM)
    k_nope, v = jnp.split(kv, [NOPE_DIM], axis=-1)
    k_rope = jnp.broadcast_to(k_pe[:, :, None, :], (B, L, MLA_HEADS, ROPE_DIM))
    k = rms_norm(jnp.concatenate([k_nope, k_rope], axis=-1), kn_g)
    if rope is not None:
        k = jnp.concatenate([k[..., :NOPE_DIM], apply_axial_rope(k[..., NOPE_DIM:], *rope)], axis=-1)
    return k, v


def block_attention(q, k, v):
    B, Lq, H, _ = q.shape
    n_blk = Lq // Q_BLOCK
    q_blocks = q.reshape(B, n_blk, Q_BLOCK, H, QK_DIM).transpose(1, 0, 2, 3, 4)
    scale = QK_DIM ** -0.5

    def one_block(qb):
        s = jnp.einsum('bqhd,bkhd->bhqk', qb, k, preferred_element_type=jnp.float32) * scale
        p = jax.nn.softmax(s, axis=-1)
        return jnp.einsum('bhqk,bkhd->bqhd', p.astype(v.dtype), v)

    out = lax.map(one_block, q_blocks)
    return out.transpose(1, 0, 2, 3, 4).reshape(B, Lq, H * V_DIM)


def moe_ffn(h, router_w, router_b, w_gu, b_gu, w_down, b_down):
    T, D = h.shape
    logits = (h @ router_w + router_b).astype(jnp.float32)
    top_logits, top_idx = lax.top_k(logits, TOP_K)
    gates = jax.nn.softmax(top_logits, axis=-1)
    n_pairs = T * TOP_K
    flat_e = top_idx.reshape(-1)
    flat_tok = jnp.repeat(jnp.arange(T, dtype=jnp.int32), TOP_K)
    flat_gate = gates.reshape(-1)
    order = jnp.argsort(flat_e)
    sorted_e = flat_e[order]
    counts = jnp.bincount(flat_e, length=N_EXPERTS)
    starts = jnp.cumsum(counts) - counts
    padded = (counts + MOE_BLOCK - 1) // MOE_BLOCK * MOE_BLOCK
    padded_ends = jnp.cumsum(padded)
    padded_starts = padded_ends - padded
    dest = padded_starts[sorted_e] + jnp.arange(n_pairs, dtype=jnp.int32) - starts[sorted_e]
    n_blocks = -(-n_pairs // MOE_BLOCK) + N_EXPERTS
    n_rows = n_blocks * MOE_BLOCK
    row_tok = jnp.full((n_rows,), T, jnp.int32).at[dest].set(flat_tok[order])
    row_gate = jnp.zeros((n_rows,), jnp.float32).at[dest].set(flat_gate[order])
    block_start = jnp.arange(n_blocks, dtype=jnp.int32) * MOE_BLOCK
    block_e = jnp.minimum(jnp.searchsorted(padded_ends, block_start, side='right'), N_EXPERTS - 1)
    h_pad = jnp.concatenate([h, jnp.zeros((1, D), h.dtype)], axis=0)
    xs = h_pad[row_tok].reshape(n_blocks, MOE_BLOCK, D)

    def expert_block(args):
        xb, e = args
        gu = xb @ w_gu[e] + b_gu[e]
        gate, up = jnp.split(gu, 2, axis=-1)
        gate = jnp.minimum(gate, SWIGLU_LIMIT)
        up = jnp.clip(up, -SWIGLU_LIMIT, SWIGLU_LIMIT)
        glu = gate * jax.nn.sigmoid(SWIGLU_ALPHA * gate)
        return ((up + 1.0) * glu) @ w_down[e] + b_down[e]

    ys = lax.map(expert_block, (xs, block_e)).reshape(n_rows, D)
    out = jax.ops.segment_sum(ys * row_gate[:, None], row_tok, num_segments=T + 1)[:T]
    return out.astype(h.dtype)


def setup_inputs(seed: int = 0) -> dict:
    key = jax.random.key(seed)
    ks = iter(jax.random.split(key, 40))

    def nrm(shape, scale):
        return scale * jax.random.normal(next(ks), shape, jnp.float32)

    def gain(shape):
        return 1.0 + nrm(shape, 0.02)

    L = DEPTH
    return {
        "x": nrm((BATCH, SEQ, D_MODEL), 1.0),
        "c": nrm((BATCH, D_MODEL), 1.0),
        "ctx": nrm((BATCH, CTX_LEN, D_MODEL), 1.0),
        "c_ctx": nrm((D_MODEL,), 1.0),
        "mod_w": nrm((L, D_MODEL, 6 * D_MODEL), D_MODEL ** -0.5),
        "mod_b": nrm((L, 6 * D_MODEL), 0.02),
        "norm1_g": gain((L, D_MODEL)),
        "w_in": nrm((L, D_MODEL, IN_COLS), D_MODEL ** -0.5),
        "hy_conv_w": nrm((L, HYENA_SHORT_W, HY_COLS), HYENA_SHORT_W ** -0.5),
        "hy_conv_b": nrm((L, HY_COLS), 0.02),
        "hy_f_w1": nrm((L, POS_EMB_DIM, FILTER_ORDER), POS_EMB_DIM ** -0.5),
        "hy_f_b1": nrm((L, FILTER_ORDER), 0.02),
        "hy_f_w2": nrm((L, FILTER_ORDER, FILTER_ORDER), FILTER_ORDER ** -0.5),
        "hy_f_b2": nrm((L, FILTER_ORDER), 0.02),
        "hy_f_w3": nrm((L, FILTER_ORDER, FILTER_ORDER), FILTER_ORDER ** -0.5),
        "hy_f_b3": nrm((L, FILTER_ORDER), 0.02),
        "hy_f_w4": nrm((L, FILTER_ORDER, 2 * D_HYENA), FILTER_ORDER ** -0.5),
        "hy_f_freq": gain((L, FILTER_ORDER)),
        "hy_bias": nrm((L, D_HYENA), 1.0),
        "mla_q_norm_g": gain((L, Q_RANK)),
        "mla_w_uq": nrm((L, Q_RANK, MLA_HEADS * QK_DIM), Q_RANK ** -0.5),
        "mla_kv_norm_g": gain((L, KV_RANK)),
        "mla_w_ukv": nrm((L, KV_RANK, MLA_HEADS * (NOPE_DIM + V_DIM)), KV_RANK ** -0.5),
        "qk_norm_q_g": gain((L, QK_DIM)),
        "qk_norm_k_g": gain((L, QK_DIM)),
        "w_out": nrm((L, D_MIX, D_MODEL), D_MIX ** -0.5),
        "norm2_g": gain((L, D_MODEL)),
        "router_w": nrm((L, D_MODEL, N_EXPERTS), D_MODEL ** -0.5),
        "router_b": nrm((L, N_EXPERTS), 0.01),
        "exp_w_gu": nrm((L, N_EXPERTS, D_MODEL, 2 * D_FF), D_MODEL ** -0.5),
        "exp_b_gu": nrm((L, N_EXPERTS, 2 * D_FF), 0.02),
        "exp_w_down": nrm((L, N_EXPERTS, D_FF, D_MODEL), D_FF ** -0.5),
        "exp_b_down": nrm((L, N_EXPERTS, D_MODEL), 0.02),
    }


def reference(x, c, ctx, c_ctx, mod_w, mod_b, norm1_g, w_in, hy_conv_w, hy_conv_b,
              hy_f_w1, hy_f_b1, hy_f_w2, hy_f_b2, hy_f_w3, hy_f_b3, hy_f_w4, hy_f_freq, hy_bias,
              mla_q_norm_g, mla_w_uq, mla_kv_norm_g, mla_w_ukv, qk_norm_q_g, qk_norm_k_g,
              w_out, norm2_g, router_w, router_b, exp_w_gu, exp_b_gu, exp_w_down, exp_b_down):
    rope = axial_rope_tables(x.shape[1])
    xc = ctx
    for layer in range(DEPTH):
        last = layer == DEPTH - 1
        mod = jax.nn.silu(c) @ mod_w[layer] + mod_b[layer]
        sh1, sc1, g1, sh2, sc2, g2 = jnp.split(mod[:, None, :], 6, axis=-1)
        mod_c = jax.nn.silu(c_ctx) @ mod_w[layer] + mod_b[layer]
        csh1, csc1, cg1, csh2, csc2, cg2 = jnp.split(mod_c, 6, axis=-1)
        hy_p = (hy_conv_w[layer], hy_conv_b[layer], hy_f_w1[layer], hy_f_b1[layer],
                hy_f_w2[layer], hy_f_b2[layer], hy_f_w3[layer], hy_f_b3[layer],
                hy_f_w4[layer], hy_f_freq[layer], hy_bias[layer])
        q_p = (mla_q_norm_g[layer], mla_w_uq[layer], qk_norm_q_g[layer])
        kv_p = (mla_kv_norm_g[layer], mla_w_ukv[layer], qk_norm_k_g[layer])
        moe_p = (router_w[layer], router_b[layer], exp_w_gu[layer], exp_b_gu[layer],
                 exp_w_down[layer], exp_b_down[layer])
        w_in_l = w_in[layer]

        hc = modulate(rms_norm(xc, norm1_g[layer]), csh1, csc1)
        if last:
            ckv_c, kpe_c = jnp.split(hc @ w_in_l[:, KV_COL:], [KV_RANK], axis=-1)
        else:
            hy_c, cq_c, ckv_c, kpe_c = jnp.split(hc @ w_in_l, [HY_COLS, KV_COL, PE_COL], axis=-1)
        k_c, v_c = mla_keys_values(ckv_c, kpe_c, *kv_p, rope=None)

        h = modulate(rms_norm(x, norm1_g[layer]), sh1, sc1)
        hy, cq, ckv, kpe = jnp.split(h @ w_in_l, [HY_COLS, KV_COL, PE_COL], axis=-1)
        y_hy = hyena_mixer(hy, *hy_p)
        q = mla_queries(cq, *q_p, rope=rope)
        k, v = mla_keys_values(ckv, kpe, *kv_p, rope=rope)
        y_att = block_attention(q, jnp.concatenate([k, k_c], axis=1),
                                jnp.concatenate([v, v_c], axis=1))
        x_new = x + g1 * (jnp.concatenate([y_hy, y_att], axis=-1) @ w_out[layer])
        h2 = modulate(rms_norm(x_new, norm2_g[layer]), sh2, sc2)
        x_new = x_new + g2 * moe_ffn(h2.reshape(-1, D_MODEL), *moe_p).reshape(x.shape)

        if not last:
            yc_hy = hyena_mixer(hy_c, *hy_p)
            q_c = mla_queries(cq_c, *q_p, rope=None)
            yc_att = block_attention(q_c, k_c, v_c)
            xc = xc + cg1 * (jnp.concatenate([yc_hy, yc_att], axis=-1) @ w_out[layer])
            h2c = modulate(rms_norm(xc, norm2_g[layer]), csh2, csc2)
            xc = xc + cg2 * moe_ffn(h2c.reshape(-1, D_MODEL), *moe_p).reshape(xc.shape)
        x = x_new
    return x
```

```cpp
#include <hip/hip_runtime.h>
#include <hip/hip_cooperative_groups.h>
#include <cstdio>
#include <cstdint>
namespace cg = cooperative_groups;

#define LAS __attribute__((address_space(3)))
#define HD __host__ __device__ __forceinline__
#define DEV __device__ __forceinline__
typedef unsigned short bf16_t;
typedef short bf16x8 __attribute__((ext_vector_type(8)));
typedef short s16x4 __attribute__((ext_vector_type(4)));
typedef float f32x4 __attribute__((ext_vector_type(4)));
typedef float f32x2 __attribute__((ext_vector_type(2)));
typedef float f32x16 __attribute__((ext_vector_type(16)));
typedef unsigned u32x4 __attribute__((ext_vector_type(4)));
typedef unsigned u32x2 __attribute__((ext_vector_type(2)));

constexpr int NB = 4, SEQ = 8192, DM = 1024, NTOK = NB * SEQ, CTXL = 256, SKV = SEQ + CTXL;
constexpr int DHY = 512, HYC = 1536, QRANK = 256, KVRANK = 128, ROPED = 64, NOPED = 128, QKD = 192, VDIM = 128, NHEAD = 4;
constexpr int INC = 1984, INCP = 2048, CQCOL = 1536, KVCOL = 1792, PECOL = 1920;
#ifndef HCLD_PAD
#define HCLD_PAD 128
#endif
constexpr int ACLD = 1024 + 64;
constexpr int HCLD = INCP + HCLD_PAD;
constexpr int NEXP = 32, TOPK = 4;
constexpr int NPAIR = NTOK * TOPK, MAXROWS = NPAIR + NEXP * 256;
constexpr int NTHR = 512;
constexpr size_t LDS_BYTES = 153600;
constexpr float NORM_EPS = 1e-6f;
constexpr size_t MiB = 1048576;

constexpr size_t OFF_CTL = 0;
constexpr size_t OFF_BAR = 4096;
constexpr size_t CTL_BYTES = 32768;
constexpr size_t ZERO_BYTES = CTL_BYTES;
constexpr size_t OFF_MOD = 32768;
constexpr size_t OFF_WINT = 196608;
constexpr size_t OFF_WUQT = OFF_WINT + (size_t)INCP * DM * 2;
constexpr size_t OFF_WUKVT = OFF_WUQT + 768 * 256 * 2;
constexpr size_t OFF_WOUTT = OFF_WUKVT + 1024 * 256 * 2;
constexpr size_t OFF_WRT = OFF_WOUTT + (size_t)DM * DM * 2;
constexpr size_t OFF_WGUT = OFF_WRT + 256 * 1024 * 2;
constexpr size_t OFF_WDNT = OFF_WGUT + (size_t)NEXP * 2048 * 1024 * 2;
constexpr size_t OFF_PAIRE = OFF_WDNT + (size_t)NEXP * 1024 * 1024 * 2;
constexpr size_t OFF_PAIRR = OFF_PAIRE + (size_t)NPAIR * 4;
constexpr size_t OFF_PAIRG = OFF_PAIRR + (size_t)NPAIR * 4;
constexpr size_t OFF_ROWTOK = OFF_PAIRG + (size_t)NPAIR * 4;
constexpr size_t OFF_LOGIT = OFF_ROWTOK + (size_t)NEXP * NTOK * 4;
constexpr size_t OFF_MODPART = OFF_LOGIT + (size_t)NTOK * 32 * 4;
constexpr size_t OFF_L1PART = OFF_MODPART + (size_t)32 * 5 * 6144 * 4;
constexpr size_t OFF_BIG = OFF_L1PART + (size_t)256 * 2 * 512 * 4;
constexpr size_t A_H = OFF_BIG;
constexpr size_t A_YMIX = A_H;
constexpr size_t A_HCAT = OFF_BIG + 64 * MiB;
constexpr size_t A_QRAW = A_H;
constexpr size_t A_KVRAW = OFF_BIG + 200 * MiB;
constexpr size_t A_UT = OFF_BIG + 524 * MiB;
constexpr size_t A_X0T = OFF_BIG + 296 * MiB;
constexpr size_t A_HFILT = OFF_BIG + 328 * MiB;
constexpr size_t A_YT = A_HFILT;
constexpr size_t A_HSPEC = OFF_BIG + 360 * MiB;
constexpr size_t A_QF = OFF_BIG + 393 * MiB;
constexpr size_t A_KF = OFF_BIG + 441 * MiB;
constexpr size_t A_VF = OFF_BIG + 491 * MiB;
constexpr size_t A_ACT = OFF_BIG;
constexpr size_t A_YPAIR = OFF_BIG + 290 * MiB;
constexpr size_t A_H2 = A_YPAIR;
constexpr size_t WS_NEED = OFF_BIG + 590 * MiB;

struct Params {
  const float *x, *c, *ctx, *c_ctx, *mod_w, *mod_b, *norm1_g, *w_in, *hy_conv_w, *hy_conv_b, *f_w1, *f_b1, *f_w2, *f_b2, *f_w3, *f_b3, *f_w4, *f_freq, *hy_bias,
      *q_norm_g, *w_uq, *kv_norm_g, *w_ukv, *qn_g, *kn_g, *w_out, *norm2_g, *router_w, *router_b, *w_gu, *b_gu, *w_down, *b_down;
  float* out; unsigned char* ws;
  int wv, pad_;
};

DEV unsigned f2bf(float f) { unsigned u = __builtin_bit_cast(unsigned, f); return (u + 0x7fffu + ((u >> 16) & 1u)) >> 16; }
DEV unsigned pk2(float lo, float hi) { return f2bf(lo) | (f2bf(hi) << 16); }
DEV float bf2f(unsigned h) { return __builtin_bit_cast(float, h << 16); }
DEV float bflo(unsigned w) { return __builtin_bit_cast(float, w << 16); }
DEV float bfhi(unsigned w) { return __builtin_bit_cast(float, w & 0xffff0000u); }
DEV unsigned cvt_pk_bf16(float lo, float hi) { unsigned r; asm volatile("v_cvt_pk_bf16_f32 %0, %1, %2" : "=v"(r) : "v"(lo), "v"(hi)); return r; }
template <int O> DEV float swz_xor(float v) { return __builtin_bit_cast(float, __builtin_amdgcn_ds_swizzle(__builtin_bit_cast(int, v), (O << 10) | 0x1F)); }
DEV float half_sum(float v) { auto rr = __builtin_amdgcn_permlane32_swap(__float_as_uint(v), __float_as_uint(v), false, false); const unsigned a = rr[0], b = rr[1]; return __uint_as_float(a) + __uint_as_float(b); }
DEV float half_max(float v) { auto rr = __builtin_amdgcn_permlane32_swap(__float_as_uint(v), __float_as_uint(v), false, false); const unsigned a = rr[0], b = rr[1]; return fmaxf(__uint_as_float(a), __uint_as_float(b)); }
DEV float wave_sum(float v) { v += swz_xor<16>(v); v += swz_xor<8>(v); v += swz_xor<4>(v); v += swz_xor<2>(v); v += swz_xor<1>(v); return half_sum(v); }
DEV float wave_max(float v) { v = fmaxf(v, swz_xor<16>(v)); v = fmaxf(v, swz_xor<8>(v)); v = fmaxf(v, swz_xor<4>(v)); v = fmaxf(v, swz_xor<2>(v)); v = fmaxf(v, swz_xor<1>(v)); return half_max(v); }
DEV int otid(int wv) { int t; asm volatile("v_mbcnt_lo_u32_b32 %0, -1, 0\n\tv_mbcnt_hi_u32_b32 %0, -1, %0" : "=v"(t)); return t | (wv << 6); }
#if defined(__HIP_DEVICE_COMPILE__)
DEV void p0_mod(const Params& p, LAS unsigned char* lds, int first, int step) {
  LAS float* sv = (LAS float*)lds;
  float* part = (float*)(p.ws + OFF_MODPART);
  const int tid = otid(p.wv);
  for (int it = first; it < 256; it += step) {
    const int cgp = it & 7, kgp = it >> 3, k0 = kgp * 32, c0 = cgp * 768;
    if (tid < 160) { const int r = tid >> 5, k = k0 + (tid & 31); const float v = r < 4 ? p.c[r * 1024 + k] : p.c_ctx[k]; sv[tid] = v / (1.f + expf(-v)); }
    __syncthreads();
    const bool two = tid < 256; float w0[32], w1[32];
#pragma unroll
    for (int k = 0; k < 32; ++k) { w0[k] = p.mod_w[(size_t)(k0 + k) * 6144 + c0 + tid]; w1[k] = two ? p.mod_w[(size_t)(k0 + k) * 6144 + c0 + 512 + tid] : 0.f; }
    float a0[5] = {}, a1[5] = {};
#pragma unroll
    for (int k = 0; k < 32; ++k)
#pragma unroll
      for (int r = 0; r < 5; ++r) { const float s = sv[r * 32 + k]; a0[r] += s * w0[k]; a1[r] += s * w1[k]; }
    const float b0 = kgp == 0 ? p.mod_b[c0 + tid] : 0.f, b1 = (kgp == 0 && two) ? p.mod_b[c0 + 512 + tid] : 0.f;
#pragma unroll
    for (int r = 0; r < 5; ++r) { part[(size_t)(kgp * 5 + r) * 6144 + c0 + tid] = a0[r] + b0; if (two) part[(size_t)(kgp * 5 + r) * 6144 + c0 + 512 + tid] = a1[r] + b1; }
    __syncthreads();
  }
}

DEV void p0b_reduce(const Params& p, LAS unsigned char* lds) {
  const float* part = (const float*)(p.ws + OFF_MODPART); const float* l1part = (const float*)(p.ws + OFF_L1PART);
  float* mod = (float*)(p.ws + OFF_MOD); float* l1sum = (float*)(p.ws + OFF_CTL + 256);
  LAS float* red = (LAS float*)lds;
  const int tid = otid(p.wv), wid = tid >> 6, lane = tid & 63;
  for (int idx = blockIdx.x * NTHR + tid; idx < 5 * 6144; idx += gridDim.x * NTHR) { float v[32];
#pragma unroll
    for (int g = 0; g < 32; ++g) v[g] = part[(size_t)g * 5 * 6144 + idx];
    float s = 0.f;
#pragma unroll
    for (int g = 0; g < 32; ++g) s += v[g];
    mod[idx] = s; }
  for (int c0 = blockIdx.x * 2; c0 < 512; c0 += gridDim.x * 2) {
    const float s0 = wave_sum(l1part[(size_t)tid * 512 + c0]), s1 = wave_sum(l1part[(size_t)tid * 512 + c0 + 1]);
    if (lane == 0) { red[wid] = s0; red[8 + wid] = s1; }
    __syncthreads();
    if (tid < 2) { float s = 0.f;
#pragma unroll
      for (int w = 0; w < 8; ++w) s += red[tid * 8 + w];
      l1sum[c0 + tid] = s; }
    __syncthreads();
  }
}

struct TItem { const float* src; bf16_t* dst; const float* kscale; int Ksrc, Nsrc, ldd, k0, n0, gu; };
DEV TItem titem_decode(const Params& p, int it) {
  constexpr int S0 = 128, S1 = S0 + 12, S2 = S1 + 16, S3 = S2 + 64, S4 = S3 + 16, S5 = S4 + 4096;
  TItem t; t.gu = 0; t.kscale = nullptr;
  if (it < S0) { t.src = p.w_in; t.dst = (bf16_t*)(p.ws + OFF_WINT); t.Ksrc = 1024; t.Nsrc = INC; t.ldd = 1024; t.k0 = (it >> 4) * 128; t.n0 = (it & 15) * 128; }
  else if (it < S1) { const int j = it - S0; t.src = p.w_uq; t.kscale = p.q_norm_g; t.dst = (bf16_t*)(p.ws + OFF_WUQT); t.Ksrc = 256; t.Nsrc = 768; t.ldd = 256; t.k0 = (j / 6) * 128; t.n0 = (j % 6) * 128; }
  else if (it < S2) { const int j = (it - S1) & 7; t.src = p.w_ukv; t.kscale = p.kv_norm_g; t.dst = (bf16_t*)(p.ws + OFF_WUKVT); t.Ksrc = 128; t.Nsrc = 1024; t.ldd = 128; t.k0 = 0; t.n0 = j * 128; }
  else if (it < S3) { const int j = it - S2; t.src = p.w_out; t.dst = (bf16_t*)(p.ws + OFF_WOUTT); t.Ksrc = 1024; t.Nsrc = 1024; t.ldd = 1024; t.k0 = (j >> 3) * 128; t.n0 = (j & 7) * 128; }
  else if (it < S4) { const int j = it - S3; t.src = p.router_w; t.dst = (bf16_t*)(p.ws + OFF_WRT); t.Ksrc = 1024; t.Nsrc = 32; t.ldd = 1024; t.k0 = (j >> 1) * 128; t.n0 = (j & 1) * 128; }
  else if (it < S5) { const int j = it - S4, e = j >> 7, r = j & 127; t.src = p.w_gu + (size_t)e * 1024 * 2048; t.dst = (bf16_t*)(p.ws + OFF_WGUT) + (size_t)e * 2048 * 1024; t.Ksrc = 1024; t.Nsrc = 2048; t.ldd = 1024; t.k0 = (r >> 4) * 128; t.n0 = (r & 15) * 128; t.gu = 1; }
  else { const int j = it - S5, e = j >> 6, r = j & 63; t.src = p.w_down + (size_t)e * 1024 * 1024; t.dst = (bf16_t*)(p.ws + OFF_WDNT) + (size_t)e * 1024 * 1024; t.Ksrc = 1024; t.Nsrc = 1024; t.ldd = 1024; t.k0 = (r >> 3) * 128; t.n0 = (r & 7) * 128; }
  return t;
}
constexpr int T_ITEMS = 128 + 12 + 16 + 64 + 16 + 4096 + 2048;
DEV void titem_load(const TItem& t, int tid, f32x4 (&va)[4], f32x4 (&vb)[4]) {
  const int rb = tid >> 5, c4 = (tid & 31) * 4; const bool okn = (t.n0 + c4) < t.Nsrc;
#pragma unroll
  for (int j = 0; j < 4; ++j) { const int k = t.k0 + 2 * rb + 32 * j;
    va[j] = (okn && k < t.Ksrc) ? *(const f32x4*)(t.src + (size_t)k * t.Nsrc + t.n0 + c4) : (f32x4){0.f, 0.f, 0.f, 0.f};
    vb[j] = (okn && (k + 1) < t.Ksrc) ? *(const f32x4*)(t.src + (size_t)(k + 1) * t.Nsrc + t.n0 + c4) : (f32x4){0.f, 0.f, 0.f, 0.f};
    if (t.kscale) { const float s0 = k < t.Ksrc ? t.kscale[k] : 0.f, s1 = (k + 1) < t.Ksrc ? t.kscale[k + 1] : 0.f; va[j] = va[j] * s0; vb[j] = vb[j] * s1; } }
}
DEV void titem_process(const TItem& cur, int tid, LAS unsigned* tile, const f32x4 (&va)[4], const f32x4 (&vb)[4]) {
  const int rb = tid >> 5, c4 = (tid & 31) * 4;
#pragma unroll
  for (int j = 0; j < 4; ++j) { const int w = rb + 16 * j;
#pragma unroll
    for (int e = 0; e < 4; ++e) tile[(c4 + e) * 68 + (w ^ ((((c4 + e) >> 3) & 3) << 2))] = pk2(va[j][e], vb[j][e]); }
}
DEV void titem_store(const TItem& cur, int tid, const LAS unsigned* tile) {
  const int n = tid >> 2, q = (tid & 3) * 16, ng = cur.n0 + n; int drow;
  if (cur.gu) { const int j = ng & 1023, up = ng >> 10; drow = ((j >> 7) << 8) + (up << 7) + (j & 127); } else drow = ng;
  const LAS u32x4* srow = (const LAS u32x4*)(tile + n * 68 + q);
  u32x4* d = (u32x4*)(cur.dst + (size_t)drow * cur.ldd + cur.k0 + q * 2);
  const int sx = (n >> 3) & 3;
  const u32x4 w0 = srow[0 ^ sx], w1 = srow[1 ^ sx], w2 = srow[2 ^ sx], w3 = srow[3 ^ sx];
  d[0] = w0; d[1] = w1; d[2] = w2; d[3] = w3;
}
DEV void p0_transposes(const Params& p, LAS unsigned char* lds) {
  LAS unsigned* tile = (LAS unsigned*)lds;
  LAS int* q = (LAS int*)(lds + 36864);
  unsigned* tq = (unsigned*)(p.ws + OFF_CTL + 128);
  const int tid = otid(p.wv);
  if (tid == 0) { q[0] = (int)atomicAdd(tq, 1u); q[1] = (int)atomicAdd(tq, 1u); }
  __syncthreads();
  int itA = q[0], itB = q[1];
  if (itA >= T_ITEMS) return;
  TItem cA = titem_decode(p, itA), cB = cA; f32x4 vaA[4], vbA[4], vaB[4], vbB[4];
  titem_load(cA, tid, vaA, vbA);
  if (itB < T_ITEMS) { cB = titem_decode(p, itB); titem_load(cB, tid, vaB, vbB); }
  for (;;) {
    titem_process(cA, tid, tile, vaA, vbA); if (tid == 0) q[0] = (int)atomicAdd(tq, 1u); __syncthreads();
    const TItem dA = cA; const int nA = q[0]; if (nA < T_ITEMS) { cA = titem_decode(p, nA); titem_load(cA, tid, vaA, vbA); }
    titem_store(dA, tid, tile); __syncthreads();
    if (itB >= T_ITEMS) break;
    titem_process(cB, tid, tile, vaB, vbB); if (tid == 0) q[1] = (int)atomicAdd(tq, 1u); __syncthreads();
    const TItem dB = cB; const int nB = q[1]; if (nB < T_ITEMS) { cB = titem_decode(p, nB); titem_load(cB, tid, vaB, vbB); }
    titem_store(dB, tid, tile); __syncthreads();
    if (nA >= T_ITEMS) break;
    itA = nA; itB = nB;
  }
}

template <int KP, int KREAL> DEV void filt_layer(const LAS float* inT, const float* __restrict__ w, const float* __restrict__ bias, const float* __restrict__ freq, LAS float* outT, int wid, int lane) {
  const int mt = wid & 1, nt = wid >> 1, x = lane & 15, q = lane >> 4, j = nt * 16 + x;
  f32x4 acc = {0.f, 0.f, 0.f, 0.f};
#pragma unroll
  for (int kk = 0; kk < KP / 4; ++kk) { const int k = 4 * kk + q; const float a = inT[k * 33 + mt * 16 + x]; const float b = (k < KREAL) ? w[k * 64 + j] : 0.f;
    acc = __builtin_amdgcn_mfma_f32_16x16x4f32(a, b, acc, 0, 0, 0); }
  const float bj = bias[j], fj = freq[j];
#pragma unroll
  for (int r = 0; r < 4; ++r) outT[j * 33 + mt * 16 + q * 4 + r] = sinf(fj * (acc[r] + bj));
}
DEV void p0_filters(const Params& p, LAS unsigned char* lds, int first, int step) {
  LAS float* zsT = (LAS float*)lds;
  LAS float* haT = zsT + 36 * 33;
  LAS float* hbT = haT + 64 * 33;
  LAS float* hcT = hbT + 64 * 33;
  LAS float* ot = hcT + 64 * 33;
  float* hfilt = (float*)(p.ws + A_HFILT); float* l1part = (float*)(p.ws + OFF_L1PART);
  const int tid = otid(p.wv), wid = p.wv, lane = tid & 63, l31 = lane & 31, lh = lane >> 5;
  constexpr float MIN_DECAY = -15.350567286626973f, MAX_DECAY = -3.0701134573253946f;
  for (int tb = first; tb < 256; tb += step) {
    const int t0 = tb * 32;
    for (int i = tid; i < 36 * 32; i += NTHR) { const int j = i >> 5, tt = i & 31, t = t0 + tt; float val = 0.f;
      if (j == 0) val = (float)t * (1.0f / 8191.0f);
      else if (j < 33) { const int bnd = (j - 1) & 15; const float f = 1e-4f + (float)bnd * ((15.0f - 1e-4f) / 15.0f); const float wa = 6.283185307179586f * (float)t * (1.0f / 8192.0f); const float arg = f * wa; val = j <= 16 ? cosf(arg) : -sinf(arg); }
      zsT[j * 33 + tt] = val; }
    __syncthreads();
    filt_layer<36, 33>(zsT, p.f_w1, p.f_b1, p.f_freq, haT, wid, lane); __syncthreads();
    filt_layer<64, 64>(haT, p.f_w2, p.f_b2, p.f_freq, hbT, wid, lane); __syncthreads();
    filt_layer<64, 64>(hbT, p.f_w3, p.f_b3, p.f_freq, hcT, wid, lane); __syncthreads();
    float av[32];
#pragma unroll
    for (int kk = 0; kk < 32; ++kk) av[kk] = hcT[(2 * kk + lh) * 33 + l31];
#pragma unroll 1
    for (int dir = 0; dir < 2; ++dir) {
      const int cb = wid * 64;
      const float* __restrict__ wb = p.f_w4 + (size_t)lh * 1024 + dir * 512 + cb + l31;
      f32x16 d0, d1;
#pragma unroll
      for (int r = 0; r < 16; ++r) { d0[r] = 0.f; d1[r] = 0.f; }
#pragma unroll
      for (int kk = 0; kk < 32; ++kk) { const float b0 = wb[(size_t)kk * 2048], b1 = wb[(size_t)kk * 2048 + 32];
        d0 = __builtin_amdgcn_mfma_f32_32x32x2f32(av[kk], b0, d0, 0, 0, 0); d1 = __builtin_amdgcn_mfma_f32_32x32x2f32(av[kk], b1, d1, 0, 0, 0); }
#pragma unroll
      for (int u = 0; u < 2; ++u) { const int c = cb + u * 32 + l31; const float adelta = fabsf(MIN_DECAY + (float)c * ((MAX_DECAY - MIN_DECAY) / 511.0f)); float l1 = 0.f;
#pragma unroll
        for (int r = 0; r < 16; ++r) { const int tt = (r & 3) + 8 * (r >> 2) + 4 * lh; const float val = (u ? d1[r] : d0[r]) * expf(-((float)(t0 + tt) * (1.0f / 8191.0f)) * adelta);
          ot[tt * 513 + c] = val; l1 += fabsf(val); }
        l1 = half_sum(l1);
        if (lh == 0) l1part[(size_t)(tb * 2 + dir) * 512 + c] = l1; }
      __syncthreads();
      { const int tt = tid & 31, cg0 = tid >> 5;
#pragma unroll 4
        for (int cc = cg0; cc < 512; cc += 16) hfilt[((size_t)(dir * 512 + cc)) * 8192 + t0 + tt] = ot[tt * 513 + cc]; }
      __syncthreads();
    }
  }
}

DEV void p1_ctx(const Params& p, LAS unsigned char* lds) {
  LAS float* hcs = (LAS float*)lds;
  LAS float* prj = hcs + 4096;
  LAS float* lat = prj + 8 * 4 * 192;
  LAS float* cn = lat + 4 * 192;
  LAS float* kvs = cn + 4 * 128;
  const float* mod = (const float*)(p.ws + OFF_MOD) + 4 * 6144;
  bf16_t* kf = (bf16_t*)(p.ws + A_KF); bf16_t* vf = (bf16_t*)(p.ws + A_VF);
  const int tid = otid(p.wv), wid = tid >> 6, lane = tid & 63;
  for (int it = blockIdx.x; it < 256; it += gridDim.x) {
    if (wid < 4) { const int r = it * 4 + wid; const float* xr = p.ctx + (size_t)r * 1024; f32x4 v[4]; float ss = 0.f;
#pragma unroll
      for (int q = 0; q < 4; ++q) { v[q] = *(const f32x4*)(xr + q * 256 + lane * 4); ss += v[q][0] * v[q][0] + v[q][1] * v[q][1] + v[q][2] * v[q][2] + v[q][3] * v[q][3]; }
      ss = wave_sum(ss); const float rs = rsqrtf(ss * (1.0f / 1024.0f) + NORM_EPS);
#pragma unroll
      for (int q = 0; q < 4; ++q)
#pragma unroll
        for (int j = 0; j < 4; ++j) { const int col = q * 256 + lane * 4 + j; hcs[wid * 1024 + col] = v[q][j] * rs * p.norm1_g[col] * (1.0f + mod[1024 + col]) + mod[col]; } }
    __syncthreads();
    { const int kp = wid; float a[3][4] = {}; const float* w = p.w_in + (size_t)(kp * 128) * INC + KVCOL + lane;
#pragma unroll 1
      for (int k0 = 0; k0 < 128; k0 += 8) { float wv[8][3];
#pragma unroll
        for (int u = 0; u < 8; ++u)
#pragma unroll
          for (int cgi = 0; cgi < 3; ++cgi) wv[u][cgi] = w[(size_t)(k0 + u) * INC + cgi * 64];
#pragma unroll
        for (int u = 0; u < 8; ++u)
#pragma unroll
          for (int r = 0; r < 4; ++r) { const float hv = hcs[r * 1024 + kp * 128 + k0 + u];
#pragma unroll
            for (int cgi = 0; cgi < 3; ++cgi) a[cgi][r] += hv * wv[u][cgi]; } }
#pragma unroll
      for (int cgi = 0; cgi < 3; ++cgi)
#pragma unroll
        for (int r = 0; r < 4; ++r) prj[(kp * 4 + r) * 192 + cgi * 64 + lane] = a[cgi][r]; }
    __syncthreads();
    for (int i = tid; i < 4 * 192; i += NTHR) { float s = 0.f;
#pragma unroll
      for (int kp = 0; kp < 8; ++kp) s += prj[kp * 768 + i];
      lat[i] = s; }
    __syncthreads();
    if (wid < 4) { const float a = lat[wid * 192 + lane], b = lat[wid * 192 + 64 + lane]; const float ss = wave_sum(a * a + b * b); const float rs = rsqrtf(ss * (1.0f / 128.0f) + NORM_EPS);
      cn[wid * 128 + lane] = a * rs * p.kv_norm_g[lane]; cn[wid * 128 + 64 + lane] = b * rs * p.kv_norm_g[64 + lane]; }
    __syncthreads();
    { float a[2][4] = {};
#pragma unroll 1
      for (int k0 = 0; k0 < 128; k0 += 16) { float w0[16], w1[16];
#pragma unroll
        for (int u = 0; u < 16; ++u) { w0[u] = p.w_ukv[(k0 + u) * 1024 + tid]; w1[u] = p.w_ukv[(k0 + u) * 1024 + 512 + tid]; }
#pragma unroll
        for (int u = 0; u < 16; ++u)
#pragma unroll
          for (int r = 0; r < 4; ++r) { const float cv = cn[r * 128 + k0 + u]; a[0][r] += cv * w0[u]; a[1][r] += cv * w1[u]; } }
#pragma unroll
      for (int r = 0; r < 4; ++r) { kvs[r * 1024 + tid] = a[0][r]; kvs[r * 1024 + 512 + tid] = a[1][r]; } }
    __syncthreads();
#pragma unroll 1
    for (int q = 0; q < 2; ++q) { const int pr = wid * 2 + q, r = pr >> 2, h = pr & 3; const int row = it * 4 + r, b = row >> 8, j = row & 255;
      const float e0 = kvs[r * 1024 + h * 256 + lane], e1 = kvs[r * 1024 + h * 256 + 64 + lane], e2 = lat[r * 192 + 128 + lane];
      const float ss = wave_sum(e0 * e0 + e1 * e1 + e2 * e2); const float rs = rsqrtf(ss * (1.0f / 192.0f) + NORM_EPS);
      bf16_t* kd = kf + ((size_t)(b * SKV + SEQ + j) * NHEAD + h) * QKD;
      kd[lane] = (bf16_t)f2bf(e0 * rs * p.kn_g[lane]); kd[64 + lane] = (bf16_t)f2bf(e1 * rs * p.kn_g[64 + lane]); kd[128 + lane] = (bf16_t)f2bf(e2 * rs * p.kn_g[128 + lane]);
      bf16_t* vd = vf + ((size_t)(b * SKV + SEQ + j) * NHEAD + h) * VDIM;
      vd[lane] = (bf16_t)f2bf(kvs[r * 1024 + h * 256 + 128 + lane]); vd[64 + lane] = (bf16_t)f2bf(kvs[r * 1024 + h * 256 + 192 + lane]); }
    __syncthreads();
  }
}

DEV void rows_norm_mod(const float* __restrict__ src, const float* __restrict__ g, const float* __restrict__ mod_shift_off0, int shift_off, int scale_off, bf16_t* __restrict__ dst, int wv) {
  constexpr int RB = 4;
  const int tid = otid(wv), wid = tid >> 6, lane = tid & 63;
  for (int r0 = (blockIdx.x * 8 + wid) * RB; r0 < NTOK; r0 += gridDim.x * 8 * RB) {
    f32x4 v[RB][4];
#pragma unroll
    for (int j = 0; j < RB; ++j)
#pragma unroll
      for (int q = 0; q < 4; ++q) v[j][q] = *(const f32x4*)(src + (size_t)(r0 + j) * 1024 + q * 256 + lane * 4);
    const float* mrow = mod_shift_off0 + (size_t)(r0 >> 13) * 6144;
    f32x4 gg[4], sc[4], sh[4];
#pragma unroll
    for (int q = 0; q < 4; ++q) { const int col = q * 256 + lane * 4; gg[q] = *(const f32x4*)(g + col); sc[q] = *(const f32x4*)(mrow + scale_off + col); sh[q] = *(const f32x4*)(mrow + shift_off + col); }
#pragma unroll
    for (int j = 0; j < RB; ++j) {
      float ss = 0.f;
#pragma unroll
      for (int q = 0; q < 4; ++q) ss += v[j][q][0] * v[j][q][0] + v[j][q][1] * v[j][q][1] + v[j][q][2] * v[j][q][2] + v[j][q][3] * v[j][q][3];
      ss = wave_sum(ss); const float rs = rsqrtf(ss * (1.0f / 1024.0f) + NORM_EPS);
#pragma unroll
      for (int q = 0; q < 4; ++q) { float o[4];
#pragma unroll
        for (int e = 0; e < 4; ++e) o[e] = v[j][q][e] * rs * gg[q][e] * (1.0f + sc[q][e]) + sh[q][e];
        u32x2 w; w.x = pk2(o[0], o[1]); w.y = pk2(o[2], o[3]); *(u32x2*)(dst + (size_t)(r0 + j) * 1024 + q * 256 + lane * 4) = w; }
    }
  }
}
struct cpx { float x, y; };
HD cpx cmul(cpx a, cpx b) { return cpx{a.x * b.x - a.y * b.y, a.x * b.y + a.y * b.x}; }
HD cpx cadd(cpx a, cpx b) { return cpx{a.x + b.x, a.y + b.y}; }
HD cpx csub(cpx a, cpx b) { return cpx{a.x - b.x, a.y - b.y}; }
HD cpx cconj(cpx a) { return cpx{a.x, -a.y}; }
DEV cpx LDC(const LAS f32x2* a, int i) { const f32x2 v = a[i]; return cpx{v.x, v.y}; }
DEV void STC(LAS f32x2* a, int i, cpx v) { a[i] = (f32x2){v.x, v.y}; }
constexpr int FFT_N = 16384;
HD int fidx(int p) { return p + ((p >> 6) << 2); }
constexpr int FFT_LDS_ELEMS = FFT_N + (FFT_N >> 6) * 4;
HD int brev14(int k) { return (int)(__builtin_bitreverse32((unsigned)k) >> 18); }
HD cpx twid(float frac, float sign) { float s, c; sincospif(2.0f * frac, &s, &c); return cpx{c, sign * s}; }

template <bool INV> HD void r16(cpx (&v)[16], cpx w1f) {
  const float sg = INV ? 1.f : -1.f;
  const cpx w1 = INV ? cconj(w1f) : w1f, w2 = cmul(w1, w1), w4 = cmul(w2, w2), w8 = cmul(w4, w4);
  const float C16[8] = {1.f, 0.92387953251f, 0.70710678119f, 0.38268343236f, 0.f, -0.38268343236f, -0.70710678119f, -0.92387953251f};
  const float S16[8] = {0.f, 0.38268343236f, 0.70710678119f, 0.92387953251f, 1.f, 0.92387953251f, 0.70710678119f, 0.38268343236f};
  if (!INV) {
#pragma unroll
    for (int m = 0; m < 8; ++m) { cpx a = v[m], b = v[m + 8]; cpx tw = cmul(w1, cpx{C16[m], sg * S16[m]}); v[m] = cadd(a, b); v[m + 8] = cmul(csub(a, b), tw); }
#pragma unroll
    for (int g = 0; g < 16; g += 8)
#pragma unroll
      for (int m = 0; m < 4; ++m) { cpx a = v[g + m], b = v[g + m + 4]; cpx tw = cmul(w2, cpx{C16[2 * m], sg * S16[2 * m]}); v[g + m] = cadd(a, b); v[g + m + 4] = cmul(csub(a, b), tw); }
#pragma unroll
    for (int g = 0; g < 16; g += 4)
#pragma unroll
      for (int m = 0; m < 2; ++m) { cpx a = v[g + m], b = v[g + m + 2]; cpx tw = cmul(w4, cpx{C16[4 * m], sg * S16[4 * m]}); v[g + m] = cadd(a, b); v[g + m + 2] = cmul(csub(a, b), tw); }
#pragma unroll
    for (int g = 0; g < 16; g += 2) { cpx a = v[g], b = v[g + 1]; v[g] = cadd(a, b); v[g + 1] = cmul(csub(a, b), w8); }
  } else {
#pragma unroll
    for (int g = 0; g < 16; g += 2) { cpx a = v[g], b = cmul(v[g + 1], w8); v[g] = cadd(a, b); v[g + 1] = csub(a, b); }
#pragma unroll
    for (int g = 0; g < 16; g += 4)
#pragma unroll
      for (int m = 0; m < 2; ++m) { cpx tw = cmul(w4, cpx{C16[4 * m], sg * S16[4 * m]}); cpx a = v[g + m], b = cmul(v[g + m + 2], tw); v[g + m] = cadd(a, b); v[g + m + 2] = csub(a, b); }
#pragma unroll
    for (int g = 0; g < 16; g += 8)
#pragma unroll
      for (int m = 0; m < 4; ++m) { cpx tw = cmul(w2, cpx{C16[2 * m], sg * S16[2 * m]}); cpx a = v[g + m], b = cmul(v[g + m + 4], tw); v[g + m] = cadd(a, b); v[g + m + 4] = csub(a, b); }
#pragma unroll
    for (int m = 0; m < 8; ++m) { cpx tw = cmul(w1, cpx{C16[m], sg * S16[m]}); cpx a = v[m], b = cmul(v[m + 8], tw); v[m] = cadd(a, b); v[m + 8] = csub(a, b); }
  }
}
template <bool INV, int LOGS, class ARR> HD void fft_pass16(ARR fz, int tid) {
  constexpr int stride = 1 << LOGS;
#pragma unroll 1
  for (int q = 0; q < 2; ++q) {
    const int bf = tid + q * 512;
    const int i0p = bf & (stride - 1), blk = bf >> LOGS;
    const int i0 = blk * (16 * stride) + i0p;
    constexpr int MOFF = LOGS >= 6 ? stride + (stride >> 6) * 4 : stride;
    const int b0 = fidx(i0);
    cpx v[16];
#pragma unroll
    for (int m = 0; m < 16; ++m) v[m] = LDC(fz, b0 + m * MOFF);
    r16<INV>(v, LDC(fz, FFT_LDS_ELEMS + (LOGS == 10 ? i0p : LOGS == 6 ? 1024 + i0p : 1088 + i0p)));
#pragma unroll
    for (int m = 0; m < 16; ++m) STC(fz, b0 + m * MOFF, v[m]);
  }
}
template <bool INV, class ARR> HD void fft_pass4(ARR fz, int tid) {
#pragma unroll 1
  for (int q = 0; q < 8; ++q) {
    const int i0 = (tid + q * 512) * 4;
    cpx v0 = LDC(fz, fidx(i0)), v1 = LDC(fz, fidx(i0 + 1)), v2 = LDC(fz, fidx(i0 + 2)), v3 = LDC(fz, fidx(i0 + 3));
    if (!INV) {
      cpx a0 = cadd(v0, v2), a2 = csub(v0, v2), a1 = cadd(v1, v3), t = csub(v1, v3); cpx a3 = cpx{t.y, -t.x};
      v0 = cadd(a0, a1); v1 = csub(a0, a1); v2 = cadd(a2, a3); v3 = csub(a2, a3);
    } else {
      cpx a0 = cadd(v0, v1), a1 = csub(v0, v1), a2 = cadd(v2, v3), a3 = csub(v2, v3);
      cpx b3 = cpx{-a3.y, a3.x};
      v0 = cadd(a0, a2); v2 = csub(a0, a2); v1 = cadd(a1, b3); v3 = csub(a1, b3);
    }
    STC(fz, fidx(i0), v0); STC(fz, fidx(i0 + 1), v1); STC(fz, fidx(i0 + 2), v2); STC(fz, fidx(i0 + 3), v3);
  }
}
DEV void fft_table(LAS f32x2* fz, int tid) { for (int k = tid; k < 1024; k += NTHR) STC(fz, FFT_LDS_ELEMS + k, twid((float)k * (1.0f / 16384.0f), -1.f));
  if (tid < 64) STC(fz, FFT_LDS_ELEMS + 1024 + tid, twid((float)(16 * tid) * (1.0f / 16384.0f), -1.f)); if (tid < 4) STC(fz, FFT_LDS_ELEMS + 1088 + tid, twid((float)(256 * tid) * (1.0f / 16384.0f), -1.f));
  __syncthreads(); }
DEV void fft_fwd(LAS f32x2* fz, int tid) {
  fft_pass16<false, 10>(fz, tid); __syncthreads(); fft_pass16<false, 6>(fz, tid); __syncthreads(); fft_pass16<false, 2>(fz, tid); __syncthreads(); fft_pass4<false>(fz, tid); __syncthreads();
}
DEV void fft_inv(LAS f32x2* fz, int tid) {
  fft_pass4<true>(fz, tid); __syncthreads(); fft_pass16<true, 2>(fz, tid); __syncthreads(); fft_pass16<true, 6>(fz, tid); __syncthreads(); fft_pass16<true, 10>(fz, tid); __syncthreads();
}

DEV void p1_spectrum(const Params& p, LAS unsigned char* lds) {
  LAS f32x2* fz = (LAS f32x2*)lds; const int tid = otid(p.wv);
  const float* hfilt = (const float*)(p.ws + A_HFILT); const float* l1sum = (const float*)(p.ws + OFF_CTL + 256); cpx* hspec = (cpx*)(p.ws + A_HSPEC);
  fft_table(fz, tid);
  LAS f32x2* fzt = fz + fidx(tid);
  for (int pr = blockIdx.x; pr < 256; pr += gridDim.x) {
    const int c0 = 2 * pr, c1 = c0 + 1; const float i0 = 1.0f / l1sum[c0], i1 = 1.0f / l1sum[c1];
    const float* f0 = hfilt + (size_t)c0 * 8192; const float* f1 = hfilt + (size_t)c1 * 8192; const float* b0 = hfilt + (size_t)(512 + c0) * 8192; const float* b1 = hfilt + (size_t)(512 + c1) * 8192;
    { float a0[16], a1[16], c0v[16], c1v[16];
#pragma unroll
      for (int i = 0; i < 16; ++i) { const int n = tid + i * NTHR; a0[i] = f0[n]; a1[i] = f1[n]; const int m = 8192 - n; c0v[i] = n ? b0[m] : 0.f; c1v[i] = n ? b1[m] : 0.f; }
#pragma unroll
      for (int i = 0; i < 16; ++i) { STC(fzt, 544 * i, cpx{a0[i] * i0, a1[i] * i1}); STC(fzt + 8704, 544 * i, cpx{c0v[i] * i0, c1v[i] * i1}); } }
    __syncthreads();
    fft_fwd(fz, tid);
    for (int q = tid; q <= 8192; q += NTHR) { const int pz = q < 8192 ? 2 * q : 1; const int k = brev14(pz), kk = (FFT_N - k) & (FFT_N - 1); const cpx a = LDC(fz, fidx(pz)), b = cconj(LDC(fz, fidx(brev14(kk)))); const cpx s = cadd(a, b), d = csub(a, b); const float sc = 0.5f / (float)FFT_N;
      hspec[(size_t)c0 * 8193 + q] = cpx{s.x * sc, s.y * sc}; hspec[(size_t)c1 * 8193 + q] = cpx{d.y * sc, -d.x * sc}; }
    __syncthreads();
  }
}

DEV void p6_conv(const Params& p, LAS unsigned char* lds) {
  LAS f32x2* fz = (LAS f32x2*)lds; const int tid = otid(p.wv);
  const float* __restrict__ uT = (const float*)(p.ws + A_UT); const bf16_t* __restrict__ x0T = (const bf16_t*)(p.ws + A_X0T); const cpx* __restrict__ hspec = (const cpx*)(p.ws + A_HSPEC); bf16_t* __restrict__ yT = (bf16_t*)(p.ws + A_YT);
  fft_table(fz, tid);
  LAS f32x2* fzt = fz + fidx(tid);
  float ua0[16], ua1[16];
  int job = blockIdx.x;
  if (job < 1024) { const float* u0 = uT + ((size_t)(job & 3) * 512 + 2 * (job >> 2)) * 8192 + tid;
#pragma unroll
    for (int i = 0; i < 16; ++i) { ua0[i] = u0[i * NTHR]; ua1[i] = u0[8192 + i * NTHR]; } }
  for (; job < 1024; job += gridDim.x) {
    const int pr = job >> 2, b = job & 3, c0 = 2 * pr, c1 = c0 + 1;
#pragma unroll
    for (int i = 0; i < 16; ++i) { STC(fzt, 544 * i, cpx{ua0[i], ua1[i]}); STC(fzt + 8704, 544 * i, cpx{0.f, 0.f}); }
    int tj = tid; asm volatile("" : "+v"(tj));
    cpx h0[17], h1[17];
    { const cpx* H0 = hspec + (size_t)c0 * 8193; const cpx* H1 = hspec + (size_t)c1 * 8193;
#pragma unroll
      for (int i = 0; i < 16; ++i) { h0[i] = H0[tj + i * NTHR]; h1[i] = H1[tj + i * NTHR]; }
      h0[16] = H0[8192]; h1[16] = H1[8192]; }
    __syncthreads();
    fft_fwd(fz, tid);
#pragma unroll
    for (int i = 0; i < 17; ++i) { const int q = tj + i * NTHR; if (i < 16 || tj == 0) { const int pz = i < 16 ? 2 * q : 1; const int k = brev14(pz), kk = (FFT_N - k) & (FFT_N - 1); const int p1 = fidx(pz), p2 = fidx(brev14(kk));
      const cpx a = LDC(fz, p1), bb = cconj(LDC(fz, p2)); const cpx s = cadd(a, bb), d = csub(a, bb); const cpx U0 = cpx{0.5f * s.x, 0.5f * s.y}, U1 = cpx{0.5f * d.y, -0.5f * d.x};
      const cpx Y0 = cmul(U0, h0[i]), Y1 = cmul(U1, h1[i]);
      STC(fz, p1, cpx{Y0.x - Y1.y, Y0.y + Y1.x}); STC(fz, p2, cpx{Y0.x + Y1.y, -Y0.y + Y1.x}); } }
    unsigned xa[16], xb[16]; float na0[16], na1[16];
    { const bf16_t* x00 = x0T + ((size_t)b * 512 + c0) * 8192 + tj;
#pragma unroll
      for (int i = 0; i < 16; ++i) { xa[i] = x00[i * NTHR]; xb[i] = x00[8192 + i * NTHR]; }
      const int nj = job + gridDim.x; const int njc = nj < 1024 ? nj : job; const float* u0n = uT + ((size_t)(njc & 3) * 512 + 2 * (njc >> 2)) * 8192 + tj;
#pragma unroll
      for (int i = 0; i < 16; ++i) { na0[i] = u0n[i * NTHR]; na1[i] = u0n[8192 + i * NTHR]; } }
    __syncthreads();
    fft_inv(fz, tid);
    { const float bi0 = p.hy_bias[c0], bi1 = p.hy_bias[c1]; bf16_t* y0 = yT + ((size_t)b * 512 + c0) * 8192 + tj; bf16_t* y1 = y0 + 8192;
#pragma unroll
      for (int i = 0; i < 16; ++i) { const cpx v = LDC(fzt, 544 * i); y0[i * NTHR] = (bf16_t)f2bf((v.x + ua0[i] * bi0) * bf2f(xa[i])); y1[i * NTHR] = (bf16_t)f2bf((v.y + ua1[i] * bi1) * bf2f(xb[i])); } }
#pragma unroll
    for (int i = 0; i < 16; ++i) { ua0[i] = na0[i]; ua1[i] = na1[i]; }
    __syncthreads();
  }
}

DEV void p3_hyena_prep(const Params& p, LAS unsigned char* lds) {
  constexpr int RS = 3 * 256 + 2;
  LAS bf16_t* raw = (LAS bf16_t*)lds;
  const bf16_t* __restrict__ hcat = (const bf16_t*)(p.ws + A_HCAT); float* __restrict__ uT = (float*)(p.ws + A_UT); bf16_t* __restrict__ x0T = (bf16_t*)(p.ws + A_X0T);
  const int tid = otid(p.wv);
  for (int it = blockIdx.x; it < 1024; it += gridDim.x) {
    const int cgp = it & 1, tt = (it >> 1) & 127, b = it >> 8, t0 = tt * 64, cb = cgp * 256;
    u32x4 w[13];
#pragma unroll
    for (int i = 0; i < 13; ++i) { const int q = tid + i * NTHR; const int rr = q / 96, r2 = q - rr * 96, g = r2 >> 5, ch8 = (r2 & 31) * 8; const int t = t0 - 1 + rr;
      w[i] = (u32x4){0u, 0u, 0u, 0u}; if (q < 6336 && t >= 0 && t < SEQ) w[i] = *(const u32x4*)(hcat + ((size_t)(b * SEQ + t)) * HCLD + g * 512 + cb + ch8); }
#pragma unroll
    for (int i = 0; i < 13; ++i) { const int q = tid + i * NTHR; if (q < 6336) { const int rr = q / 96, r2 = q - rr * 96, g = r2 >> 5, ch8 = (r2 & 31) * 8;
      LAS unsigned* d = (LAS unsigned*)(raw + rr * RS + g * 256 + ch8); d[0] = w[i].x; d[1] = w[i].y; d[2] = w[i].z; d[3] = w[i].w; } }
    __syncthreads();
    { const int t = tid & 63, cq = tid >> 6;
#pragma unroll 2
      for (int j = 0; j < 32; ++j) { const int cl = cq * 32 + j, c = cb + cl; float cv[3];
#pragma unroll
        for (int g = 0; g < 3; ++g) { const int col = g * 512 + c; const float w0 = p.hy_conv_w[col], w1 = p.hy_conv_w[HYC + col], w2 = p.hy_conv_w[2 * HYC + col], bb = p.hy_conv_b[col];
          cv[g] = bf2f(raw[t * RS + g * 256 + cl]) * w0 + bf2f(raw[(t + 1) * RS + g * 256 + cl]) * w1 + bf2f(raw[(t + 2) * RS + g * 256 + cl]) * w2 + bb; }
        const size_t o = ((size_t)b * 512 + c) * 8192 + t0 + t; uT[o] = cv[1] * cv[2]; x0T[o] = (bf16_t)f2bf(cv[0]); } }
    __syncthreads();
  }
}
DEV void p7_transpose(const Params& p, LAS unsigned char* lds) {
  LAS bf16_t* tl = (LAS bf16_t*)lds;
  const bf16_t* yT = (const bf16_t*)(p.ws + A_YT); bf16_t* ymix = (bf16_t*)(p.ws + A_YMIX);
  const int tid = otid(p.wv);
  for (int it = blockIdx.x; it < 4096; it += gridDim.x) {
    const int cgp = it & 7, tt = (it >> 3) & 127, b = it >> 10, t0 = tt * 64, cb = cgp * 64;
    { const int c = tid >> 3, t8 = (tid & 7) * 8; const u32x4 w = *(const u32x4*)(yT + ((size_t)b * 512 + cb + c) * 8192 + t0 + t8);
      LAS unsigned* d = (LAS unsigned*)(tl + c * 66 + t8); d[0] = w.x; d[1] = w.y; d[2] = w.z; d[3] = w.w; }
    __syncthreads();
    { const int t = tid >> 3, c8 = (tid & 7) * 8; unsigned short e[8];
#pragma unroll
      for (int j = 0; j < 8; ++j) e[j] = tl[(c8 + j) * 66 + t];
      u32x4 w; w.x = e[0] | ((unsigned)e[1] << 16); w.y = e[2] | ((unsigned)e[3] << 16); w.z = e[4] | ((unsigned)e[5] << 16); w.w = e[6] | ((unsigned)e[7] << 16);
      *(u32x4*)(ymix + ((size_t)(b * SEQ + t0 + t)) * 1024 + cb + c8) = w; }
    __syncthreads();
  }
}
constexpr int BM = 256, BK = 64, HALF = 128, HTB = HALF * BK * 2, RING_BYTES = 8 * HTB, NXCD = 8, WGM = 8;
constexpr int TAB_OFF = RING_BYTES;
HD int lds_byte(int r, int c) { const int st = (r >> 4) * 2 + (c >> 5), rr = r & 15, cc = c & 31, ob = rr * 64 + cc * 2; return st * 1024 + (ob ^ (((ob >> 9) & 1) << 5)); }
HD void stage_rc(int b, int& R, int& C) { const int st = b / 1024, sb = b % 1024, swz = sb ^ (((sb >> 9) & 1) << 5); R = (st >> 1) * 16 + swz / 64; C = (st & 1) * 32 + (swz % 64) / 2; }
HD int perm32(int rho) { const int n = rho >> 4, i = rho & 15; return 8 * (i >> 2) + 4 * n + (i & 3); }

struct Unit { int pm, pn, e, mt; };

struct DenseOrder {
  static constexpr bool PREFETCH_ROWS = false;
  int nM, nN, nwg, G, c, K; unsigned lda; const char* Bt;
  DEV void init(int M, int N, int K_, const void* Bt_, int G_, int c_, int lda_elems = 0) { nM = M / BM; nN = N / BM; nwg = nM * nN; G = G_; c = c_; K = K_; Bt = (const char*)Bt_; lda = (unsigned)(lda_elems ? lda_elems : K_) * 2u; }
  DEV bool next(int i, Unit& u) const {
    const long L = (long)i * G + c; if (L >= nwg) return false;
    int wgid = (int)L; { const int q = nwg / NXCD, r = nwg % NXCD, xcd = wgid % NXCD, off = wgid / NXCD; wgid = (xcd < r ? xcd * (q + 1) : r * (q + 1) + (xcd - r) * q) + off; }
    const int nig = WGM * nN, gid = wgid / nig, fm = gid * WGM, gsz = (nM - fm) < WGM ? (nM - fm) : WGM;
    u.pm = fm + ((wgid % nig) % gsz); u.pn = (wgid % nig) / gsz; u.e = 0; u.mt = 0; return true;
  }
  DEV const char* bptr(const Unit& u) const { return Bt + (size_t)u.pn * BM * K * 2; }
  DEV unsigned arow_off(const Unit& u, int r) const { return (unsigned)(u.pm * BM + r) * lda; }
};
template <bool GATHER> struct GroupedOrder {
  static constexpr bool PREFETCH_ROWS = GATHER;
  int nN, G, c, K, total; unsigned lda; const char* Bt; size_t bstride; const LAS int* cnt; const LAS int* tpref; const int* rowtok;
  DEV void init(int N, int K_, const void* Bt_, const LAS int* tab, const int* rowtok_, int G_, int c_, int lda_elems = 0) { lda = (unsigned)(lda_elems ? lda_elems : K_) * 2u; nN = N / BM; K = K_; Bt = (const char*)Bt_; bstride = (size_t)N * K_ * 2; cnt = tab; tpref = tab + 32; rowtok = rowtok_; G = G_; c = c_; total = tab[64] * nN; }
  DEV bool next(int i, Unit& u) const {
    const int gx = G >> 3; const long L = (G & 7) ? (long)i * G + c : (long)i * G + (c & 7) * gx + (c >> 3); if (L >= total) return false;
    int e = 0; while (e < 31 && (int)L >= tpref[e + 1] * nN) ++e;
    const int idx = (int)L - tpref[e] * nN;
    u.e = e; u.mt = idx / nN; u.pn = idx - u.mt * nN; u.pm = tpref[e] + u.mt; return true;
  }
  DEV const char* bptr(const Unit& u) const { return Bt + (size_t)u.e * bstride + (size_t)u.pn * BM * K * 2; }
  DEV unsigned arow_off(const Unit& u, int r) const {
    if (GATHER) { const int j = u.mt * BM + r; const int tok = j < cnt[u.e] ? rowtok[u.e * NTOK + j] : 0; return (unsigned)tok * lda; }
    else return (unsigned)(u.pm * BM + r) * lda;
  }
};

struct EpiBf16 {
  static constexpr bool PERM = true;
  bf16_t* O; int ldc;
  DEV void operator()(const f32x4 (&acc)[2][2][4][2], const Unit& u, int wr, int wc, int fr, int fq) const {
    const int row0 = u.pm * BM + wr * 64 + fr, col0 = u.pn * BM + wc * 32 + 8 * fq;
#pragma unroll
    for (int ai = 0; ai < 2; ++ai)
#pragma unroll
      for (int m = 0; m < 4; ++m) { bf16_t* rowp = O + (size_t)(row0 + ai * HALF + m * 16) * ldc + col0;
#pragma unroll
        for (int bj = 0; bj < 2; ++bj) { const f32x4 v0 = acc[ai][bj][m][0], v1 = acc[ai][bj][m][1]; u32x4 w; w.x = cvt_pk_bf16(v0[0], v0[1]); w.y = cvt_pk_bf16(v0[2], v0[3]); w.z = cvt_pk_bf16(v1[0], v1[1]); w.w = cvt_pk_bf16(v1[2], v1[3]);
          *(u32x4*)(rowp + bj * HALF) = w;
          } }
  }
};
struct EpiResid {
  static constexpr bool PERM = false;
  const float* x; float* out; const float* mod;
  DEV void operator()(const f32x4 (&acc)[2][2][4][2], const Unit& u, int wr, int wc, int fr, int fq) const {
    const int row0 = u.pm * BM + wr * 64 + fr, col0 = u.pn * BM + wc * 32 + 4 * fq; const float* g = mod + (size_t)(row0 >> 13) * 6144 + 2048;
    f32x4 gv[2][2];
#pragma unroll
    for (int bj = 0; bj < 2; ++bj)
#pragma unroll
      for (int n = 0; n < 2; ++n) gv[bj][n] = *(const f32x4*)(g + col0 + bj * HALF + n * 16);
#pragma unroll
    for (int ai = 0; ai < 2; ++ai)
#pragma unroll
      for (int m = 0; m < 4; ++m) { const size_t ro = (size_t)(row0 + ai * HALF + m * 16) * 1024 + col0;
#pragma unroll
        for (int bj = 0; bj < 2; ++bj)
#pragma unroll
          for (int n = 0; n < 2; ++n) { const f32x4 xv = *(const f32x4*)(x + ro + bj * HALF + n * 16); *(f32x4*)(out + ro + bj * HALF + n * 16) = xv + gv[bj][n] * acc[ai][bj][m][n]; } }
  }
};
struct EpiLogits {
  static constexpr bool PERM = false;
  float* L;
  DEV void operator()(const f32x4 (&acc)[2][2][4][2], const Unit& u, int wr, int wc, int fr, int fq) const {
    if (wc != 0) return;
    const int row0 = u.pm * BM + wr * 64 + fr;
#pragma unroll
    for (int ai = 0; ai < 2; ++ai)
#pragma unroll
      for (int m = 0; m < 4; ++m)
#pragma unroll
        for (int n = 0; n < 2; ++n) *(f32x4*)(L + (size_t)(row0 + ai * HALF + m * 16) * 32 + n * 16 + 4 * fq) = acc[ai][0][m][n];
  }
};
struct EpiGlu {
  static constexpr bool PERM = true;
  bf16_t* O; const float* b_gu;
  DEV void operator()(const f32x4 (&acc)[2][2][4][2], const Unit& u, int wr, int wc, int fr, int fq) const {
    const int row0 = u.pm * BM + wr * 64 + fr, j0 = u.pn * HALF + wc * 32 + 8 * fq; const float* bg = b_gu + (size_t)u.e * 2048 + j0;
    const f32x4 bg0 = *(const f32x4*)(bg), bg1 = *(const f32x4*)(bg + 4), bu0 = *(const f32x4*)(bg + 1024), bu1 = *(const f32x4*)(bg + 1028);
#pragma unroll
    for (int ai = 0; ai < 2; ++ai)
#pragma unroll
      for (int m = 0; m < 4; ++m) { f32x4 o[2];
#pragma unroll
        for (int n = 0; n < 2; ++n) { f32x4 gt = acc[ai][0][m][n] + (n ? bg1 : bg0), up = acc[ai][1][m][n] + (n ? bu1 : bu0), e, r;
#pragma unroll
          for (int j = 0; j < 4; ++j) { gt[j] = fminf(gt[j], 7.0f); up[j] = __builtin_amdgcn_fmed3f(up[j], -7.0f, 7.0f); }
          const f32x4 z = gt * (-1.702f * 1.4426950408889634f);
#pragma unroll
          for (int j = 0; j < 4; ++j) e[j] = __builtin_amdgcn_exp2f(z[j]);
          const f32x4 d = e + 1.0f;
#pragma unroll
          for (int j = 0; j < 4; ++j) r[j] = __builtin_amdgcn_rcpf(d[j]);
          const f32x4 glu = gt * r; o[n] = up * glu + glu; }
        u32x4 w; w.x = cvt_pk_bf16(o[0][0], o[0][1]); w.y = cvt_pk_bf16(o[0][2], o[0][3]); w.z = cvt_pk_bf16(o[1][0], o[1][1]); w.w = cvt_pk_bf16(o[1][2], o[1][3]);
        *(u32x4*)(O + (size_t)(row0 + ai * HALF + m * 16) * ACLD + j0) = w; }
  }
};
struct EpiDown {
  static constexpr bool PERM = true;
  bf16_t* O; const float* b_down;
  DEV void operator()(const f32x4 (&acc)[2][2][4][2], const Unit& u, int wr, int wc, int fr, int fq) const {
    const int row0 = u.pm * BM + wr * 64 + fr, col0 = u.pn * BM + wc * 32 + 8 * fq; const float* bd = b_down + (size_t)u.e * 1024 + col0;
    f32x4 bv[2][2];
#pragma unroll
    for (int bj = 0; bj < 2; ++bj)
#pragma unroll
      for (int n = 0; n < 2; ++n) bv[bj][n] = *(const f32x4*)(bd + bj * HALF + 4 * n);
#pragma unroll
    for (int ai = 0; ai < 2; ++ai)
#pragma unroll
      for (int m = 0; m < 4; ++m) { bf16_t* rowp = O + (size_t)(row0 + ai * HALF + m * 16) * ACLD + col0;
#pragma unroll
        for (int bj = 0; bj < 2; ++bj) { const f32x4 v0 = acc[ai][bj][m][0] + bv[bj][0], v1 = acc[ai][bj][m][1] + bv[bj][1]; u32x4 w; w.x = cvt_pk_bf16(v0[0], v0[1]); w.y = cvt_pk_bf16(v0[2], v0[3]); w.z = cvt_pk_bf16(v1[0], v1[1]); w.w = cvt_pk_bf16(v1[2], v1[3]);
          *(u32x4*)(rowp + bj * HALF) = w; } }
  }
};

template <class Epi, class Sched>
DEV void gemm_phase(LAS unsigned char* lds, const void* Abase, const Sched& S, const Epi& E, int wv) {
  const int tid = otid(wv), wid = __builtin_amdgcn_readfirstlane(tid >> 6), lane = tid & 63, wr = wid >> 2, wc = wid & 3, fr = lane & 15, fq = lane >> 4;
  const int K = S.K, nt = K / BK;
  int Rr[2], Cc[2]; unsigned voffB[2];
#pragma unroll
  for (int i = 0; i < 2; ++i) { int R, C; stage_rc(tid * 16 + i * 8192, R, C); Rr[i] = R; Cc[i] = C; const int Rb = Epi::PERM ? ((R & ~31) + perm32(R & 31)) : R; voffB[i] = (unsigned)(Rb * K + C) * 2u; }
  const size_t kstep = (size_t)(BK * 2), hstep = (size_t)HALF * K * 2;
  const unsigned ldsw = (unsigned)wid * 1024u;
  const int aoff = lds_byte(wr * 64 + fr, fq * 8), boff = lds_byte(wc * 32 + fr, fq * 8);
  const char* Ab = (const char*)Abase;
#define G_SA(b, h) (((b) * 2 + (h)) * HTB)
#define G_SB(b, h) ((4 + (b) * 2 + (h)) * HTB)
#define G_STAGEB(bufoff, gbase) do { _Pragma("unroll") for (int _i = 0; _i < 2; ++_i) \
    __builtin_amdgcn_global_load_lds((const unsigned*)((const char*)(gbase) + voffB[_i]), (LAS unsigned*)(lds + (bufoff) + ldsw + _i * 8192), 16, 0, 0); } while (0)
#define G_STAGEA(bufoff, gbase, offs) do { _Pragma("unroll") for (int _i = 0; _i < 2; ++_i) \
    __builtin_amdgcn_global_load_lds((const unsigned*)((const char*)(gbase) + (offs)[_i]), (LAS unsigned*)(lds + (bufoff) + ldsw + _i * 8192), 16, 0, 0); } while (0)
#define G_LDA(dst, b, h) do { _Pragma("unroll") for (int m = 0; m < 4; ++m) _Pragma("unroll") for (int k = 0; k < 2; ++k) dst[m][k] = *(const LAS bf16x8*)(lds + G_SA(b, h) + aoff + m * 2048 + k * 1024); } while (0)
#define G_LDB(dst, b, h) do { _Pragma("unroll") for (int n = 0; n < 2; ++n) _Pragma("unroll") for (int k = 0; k < 2; ++k) dst[n][k] = *(const LAS bf16x8*)(lds + G_SB(b, h) + boff + n * 2048 + k * 1024); } while (0)
#define G_MMA(ai, bj, At, Bt) do { __builtin_amdgcn_s_setprio(1); _Pragma("unroll") for (int m = 0; m < 4; ++m) _Pragma("unroll") for (int n = 0; n < 2; ++n) _Pragma("unroll") for (int k = 0; k < 2; ++k) \
    acc[ai][bj][m][n] = __builtin_amdgcn_mfma_f32_16x16x32_bf16(Bt[n][k], At[m][k], acc[ai][bj][m][n], 0, 0, 0); __builtin_amdgcn_s_setprio(0); } while (0)
#define G_WAIT_V(n) asm volatile("s_waitcnt vmcnt(" #n ")" ::: "memory")
#define G_WAIT_L(n) asm volatile("s_waitcnt lgkmcnt(" #n ")" ::: "memory")
#define G_BAR __builtin_amdgcn_s_barrier()
#define G_SCHED __builtin_amdgcn_sched_barrier(0)
  Unit cur, nxt; int ui = 0;
  if (!S.next(0, cur)) return;
  f32x4 acc[2][2][4][2];
#pragma unroll
  for (int a = 0; a < 2; ++a)
#pragma unroll
    for (int b = 0; b < 2; ++b)
#pragma unroll
      for (int m = 0; m < 4; ++m)
#pragma unroll
        for (int n = 0; n < 2; ++n) acc[a][b][m][n] = (f32x4){0.f, 0.f, 0.f, 0.f};
  bf16x8 At[4][2], B0[2][2], B1[2][2];
  unsigned aN0[2] = {0u, 0u}, aN1[2] = {0u, 0u};
  unsigned aC0[2], aC1[2];
#pragma unroll
  for (int i = 0; i < 2; ++i) { aC0[i] = S.arow_off(cur, Rr[i]) + (unsigned)Cc[i] * 2u; aC1[i] = S.arow_off(cur, HALF + Rr[i]) + (unsigned)Cc[i] * 2u; }
  const char* cB = S.bptr(cur);
  G_STAGEB(G_SB(0, 0), cB); G_STAGEB(G_SB(0, 1), cB + hstep); G_STAGEA(G_SA(0, 0), Ab, aC0); G_STAGEA(G_SA(0, 1), Ab, aC1);
  if (wr == 1) G_BAR;
  G_WAIT_V(2); G_BAR;
  G_STAGEB(G_SB(1, 0), cB + kstep); G_STAGEA(G_SA(1, 0), Ab + kstep, aC0); G_STAGEB(G_SB(1, 1), cB + hstep + kstep);
  G_WAIT_V(6); G_BAR;
#define G_TRIP(t, WAITA, WAITB) do { \
      const bool last = ((t) == nt - 2); \
      const char* a1 = Ab + (size_t)((t) + 1) * kstep; \
      const char* a2 = last ? Ab : Ab + (size_t)((t) + 2) * kstep; const char* b2 = last ? nB : cB + (size_t)((t) + 2) * kstep; \
      const char* a3 = a2 + kstep; const char* b3 = b2 + kstep; \
      G_LDB(B0, 0, 0); G_LDB(B1, 0, 1); G_SCHED; G_LDA(At, 0, 0); G_STAGEA(G_SA(1, 1), a1, aC1); \
      if (last && has_next) { \
        if constexpr (Sched::PREFETCH_ROWS) { _Pragma("unroll") for (int i = 0; i < 2; ++i) { aC0[i] = aN0[i]; aC1[i] = aN1[i]; } } \
        else { _Pragma("unroll") for (int i = 0; i < 2; ++i) { aC0[i] = S.arow_off(nxt, Rr[i]) + (unsigned)Cc[i] * 2u; aC1[i] = S.arow_off(nxt, HALF + Rr[i]) + (unsigned)Cc[i] * 2u; } } \
      } \
      WAITA; G_WAIT_L(0); G_BAR; G_MMA(0, 0, At, B0); G_MMA(0, 1, At, B1); G_BAR; G_SCHED; \
      G_LDA(At, 0, 1); G_STAGEB(G_SB(0, 0), b2); G_STAGEB(G_SB(0, 1), b2 + hstep); G_STAGEA(G_SA(0, 0), a2, aC0); \
      WAITB; G_WAIT_L(0); G_BAR; G_MMA(1, 0, At, B0); G_MMA(1, 1, At, B1); G_BAR; G_SCHED; \
      G_LDB(B0, 1, 0); G_LDB(B1, 1, 1); G_SCHED; G_LDA(At, 1, 0); G_STAGEA(G_SA(0, 1), a2, aC1); \
      G_WAIT_V(8); G_WAIT_L(0); G_BAR; G_MMA(0, 0, At, B0); G_MMA(0, 1, At, B1); G_BAR; G_SCHED; \
      G_LDA(At, 1, 1); G_STAGEB(G_SB(1, 0), b3); G_STAGEB(G_SB(1, 1), b3 + hstep); G_STAGEA(G_SA(1, 0), a3, aC0); \
      G_WAIT_V(8); G_WAIT_L(0); G_BAR; G_MMA(1, 0, At, B0); G_MMA(1, 1, At, B1); G_BAR; G_SCHED; \
    } while (0)
  for (;;) {
    const bool has_next = S.next(ui + 1, nxt);
    const char* nB = has_next ? S.bptr(nxt) : cB;
    if constexpr (Sched::PREFETCH_ROWS) { if (has_next) {
#pragma unroll
      for (int i = 0; i < 2; ++i) { aN0[i] = S.arow_off(nxt, Rr[i]) + (unsigned)Cc[i] * 2u; aN1[i] = S.arow_off(nxt, HALF + Rr[i]) + (unsigned)Cc[i] * 2u; } } }
#pragma unroll 1
    for (int t = 0; t < nt; t += 2) G_TRIP(t, G_WAIT_V(8), G_WAIT_V(8));
    if (wr == 0) G_BAR;
    E(acc, cur, wr, wc, fr, fq);
    if (!has_next) break;
#pragma unroll
    for (int a = 0; a < 2; ++a)
#pragma unroll
      for (int b = 0; b < 2; ++b)
#pragma unroll
        for (int m = 0; m < 4; ++m)
#pragma unroll
          for (int n = 0; n < 2; ++n) acc[a][b][m][n] = (f32x4){0.f, 0.f, 0.f, 0.f};
    cur = nxt; cB = nB; ++ui;
    if (wr == 1) G_BAR;
  }
  G_WAIT_V(0);
  G_BAR;
#undef G_SA
#undef G_SB
#undef G_STAGEA
#undef G_STAGEB
#undef G_LDA
#undef G_LDB
#undef G_MMA
#undef G_WAIT_V
#undef G_TRIP
#undef G_WAIT_L
#undef G_BAR
#undef G_SCHED
}
constexpr float QPRE = 0.07216878364870323f * 1.4426950408889634f;
DEV void p5_qkv_final(const Params& p) {
  const bf16_t* __restrict__ qraw = (const bf16_t*)(p.ws + A_QRAW); const bf16_t* __restrict__ kvraw = (const bf16_t*)(p.ws + A_KVRAW); const bf16_t* __restrict__ hcat = (const bf16_t*)(p.ws + A_HCAT);
  bf16_t* __restrict__ qf = (bf16_t*)(p.ws + A_QF); bf16_t* __restrict__ kf = (bf16_t*)(p.ws + A_KF); bf16_t* __restrict__ vf = (bf16_t*)(p.ws + A_VF);
  constexpr int RB = 2;
  const int tid = otid(p.wv), wid = tid >> 6, lane = tid & 63;
  const int ax = lane >> 5, fi = lane & 15, second = (lane >> 4) & 1;
  const float invf = exp2f(-(float)fi * (13.287712379549449f / 16.0f));
  const float gq0 = p.qn_g[lane], gq1 = p.qn_g[64 + lane], gq2 = p.qn_g[128 + lane], gk0 = p.kn_g[lane], gk1 = p.kn_g[64 + lane], gk2 = p.kn_g[128 + lane];
  for (int r0 = (blockIdx.x * 8 + wid) * RB; r0 < NTOK; r0 += gridDim.x * 8 * RB) {
    unsigned short qe[RB][4][3], ke[RB][4][4], kp[RB]; u32x2 lq[RB]; unsigned lk[RB];
#pragma unroll
    for (int j = 0; j < RB; ++j) { const int r = r0 + j; const bf16_t* hrow = hcat + (size_t)r * HCLD;
      kp[j] = hrow[PECOL + lane]; lq[j] = *(const u32x2*)(hrow + CQCOL + lane * 4); lk[j] = *(const unsigned*)(hrow + KVCOL + lane * 2);
#pragma unroll
      for (int h = 0; h < NHEAD; ++h) { const bf16_t* s = qraw + (size_t)r * 768 + h * QKD; qe[j][h][0] = s[lane]; qe[j][h][1] = s[64 + lane]; qe[j][h][2] = s[128 + lane];
        const bf16_t* s2 = kvraw + (size_t)r * ACLD + h * 256; ke[j][h][0] = s2[lane]; ke[j][h][1] = s2[64 + lane]; ke[j][h][2] = s2[128 + lane]; ke[j][h][3] = s2[192 + lane]; } }
#pragma unroll
    for (int j = 0; j < RB; ++j) { const int r = r0 + j;
      const int b = r >> 13, t = r & 8191; const float pos = (float)(ax ? (t & 63) : (t >> 6)); float sn, cs; sincosf(pos * invf, &sn, &cs);
      const float kpe = bf2f(kp[j]);
      float rq, rk;
      { const float a = bflo(lq[j].x), bb = bfhi(lq[j].x), c = bflo(lq[j].y), d = bfhi(lq[j].y); rq = rsqrtf(wave_sum(a * a + bb * bb + c * c + d * d) * (1.0f / 256.0f) + NORM_EPS);
        const float e = bflo(lk[j]), f = bfhi(lk[j]); rk = rsqrtf(wave_sum(e * e + f * f) * (1.0f / 128.0f) + NORM_EPS); }
      const size_t kvrow = (size_t)(b * SKV + t);
#pragma unroll
      for (int h = 0; h < NHEAD; ++h) {
        { const float e0 = rq * bf2f(qe[j][h][0]), e1 = rq * bf2f(qe[j][h][1]), e2 = rq * bf2f(qe[j][h][2]);
          const float rs = rsqrtf(wave_sum(e0 * e0 + e1 * e1 + e2 * e2) * (1.0f / 192.0f) + NORM_EPS); const float n0 = e0 * rs * gq0, n1 = e1 * rs * gq1, n2 = e2 * rs * gq2;
          const float pt = swz_xor<16>(n2); const float r2 = n2 * cs + (second ? pt : -pt) * sn;
          bf16_t* d = qf + (size_t)r * 768 + h * QKD; d[lane] = (bf16_t)f2bf(n0 * QPRE); d[64 + lane] = (bf16_t)f2bf(n1 * QPRE); d[128 + lane] = (bf16_t)f2bf(r2 * QPRE); }
        { const float e0 = rk * bf2f(ke[j][h][0]), e1 = rk * bf2f(ke[j][h][1]), e2 = kpe;
          const float rs = rsqrtf(wave_sum(e0 * e0 + e1 * e1 + e2 * e2) * (1.0f / 192.0f) + NORM_EPS); const float n0 = e0 * rs * gk0, n1 = e1 * rs * gk1, n2 = e2 * rs * gk2;
          const float pt = swz_xor<16>(n2); const float r2 = n2 * cs + (second ? pt : -pt) * sn;
          bf16_t* d = kf + kvrow * 768 + h * QKD; d[lane] = (bf16_t)f2bf(n0); d[64 + lane] = (bf16_t)f2bf(n1); d[128 + lane] = (bf16_t)f2bf(r2);
          bf16_t* dv = vf + kvrow * 512 + h * VDIM; dv[lane] = (bf16_t)f2bf(rk * bf2f(ke[j][h][2])); dv[64 + lane] = (bf16_t)f2bf(rk * bf2f(ke[j][h][3])); }
      }
    }
  }
}

namespace att {
constexpr int NW = 8, QBLK = 32, KVBLK = 64;
constexpr float SCALE = 0.07216878364870323f;
constexpr int LDQ = 768, LDKK = 768, LDKV = 512, LDO = 1024;
constexpr int SHM_V = KVBLK * VDIM * 2, SHM_K = KVBLK * QKD * 2;
constexpr int SHM_ATTN = 3 * (SHM_V + SHM_K) + NW * 64 * 4;
#define KSWZ(row, colB) ((row) * 384 + ((colB) ^ ((((row) >> 1) & 7) << 4)))
#define SBAR() __builtin_amdgcn_sched_barrier(0)
DEV int crow(int r, int hi) { return (r & 3) + 8 * (r >> 2) + 4 * hi; }
DEV unsigned cvtpk(float lo, float hi) { unsigned r; asm volatile("v_cvt_pk_bf16_f32 %0, %1, %2" : "=v"(r) : "v"(lo), "v"(hi)); return r; }
constexpr float SMC = SCALE * 1.4426950408889634f;
#define EX(P, R) do { P[R] = __builtin_amdgcn_exp2f(P[R]); l_reg += P[R]; } while (0)
#define PK4(P, BASE, OUT) do { unsigned a0 = cvtpk(P[BASE + 0], P[BASE + 1]), a1 = cvtpk(P[BASE + 2], P[BASE + 3]);   \
    unsigned b0 = cvtpk(P[BASE + 4], P[BASE + 5]), b1 = cvtpk(P[BASE + 6], P[BASE + 7]);                              \
    auto r0 = __builtin_amdgcn_permlane32_swap(a0, b0, false, false); auto r1 = __builtin_amdgcn_permlane32_swap(a1, b1, false, false); \
    u32x4 w = {r0[0], r1[0], r0[1], r1[1]}; OUT = *reinterpret_cast<bf16x8*>(&w); } while (0)
#define MF(A, B, C) __builtin_amdgcn_mfma_f32_32x32x16_bf16(A, B, C, 0, 0, 0)
DEV int v_st(int k, int c) { const int kk = (k & ~0xC) | ((k & 4) << 1) | ((k & 8) >> 1); return ((kk >> 3) * 4 + (c >> 5)) * 512 + ((kk & 7) * 32 + (c & 31)) * 2; }
DEV int v_rd_base(int lane) { return ((lane & 3) << 3) | (((lane >> 2) & 3) << 6) | (((lane >> 4) & 1) << 5) | (((lane >> 5) & 1) << 8); }
constexpr int v_rd_off(int d0, int ks, int half) { return d0 * 512 + ks * 4096 + half * 2048; }
template <int OFF> DEV s16x4 tr_read(int vb) { s16x4 r; asm volatile("ds_read_b64_tr_b16 %0, %1 offset:%2" : "=&v"(r) : "v"(vb), "i"(OFF) : "memory"); return r; }
#define PKV(L, H) (bf16x8){L[0], L[1], L[2], L[3], H[0], H[1], H[2], H[3]}
#define VRD(SET, D0, H) do { SET[0] = tr_read<v_rd_off(D0, 2 * (H), 0)>(vb); SET[1] = tr_read<v_rd_off(D0, 2 * (H), 1)>(vb); SET[2] = tr_read<v_rd_off(D0, 2 * (H) + 1, 0)>(vb); SET[3] = tr_read<v_rd_off(D0, 2 * (H) + 1, 1)>(vb); } while (0)
template <int OFF> DEV bf16x8 k_read(int a) { bf16x8 r; asm volatile("ds_read_b128 %0, %1 offset:%2" : "=&v"(r) : "v"(a), "i"(OFF) : "memory"); return r; }
#define LGK(N) asm volatile("s_waitcnt lgkmcnt(" #N ")" ::: "memory")
template <class DMA> DEV void att_tile(f32x16 (&o)[4], float& l_reg, int ks, int vb, const int (&kb)[4], const bf16x8 (&qr)[12], const f32x16& cinit, const DMA& dma) {
  int ka[4];
#pragma unroll
  for (int i = 0; i < 4; ++i) ka[i] = ks + kb[i];
#define KLD(S) k_read<((((S) % 12) >> 2) * 128 + ((S) / 12) * (32 * 384))>(ka[((S) % 12) & 3])
  bf16x8 kf[6]; kf[0] = KLD(0); kf[1] = KLD(1); kf[2] = KLD(2); kf[3] = KLD(3); kf[4] = KLD(4);
  f32x16 p0, p1; bf16x8 pa0, pa1, pa2, pa3; s16x4 v0[4], v1[4], v2[4];
  kf[5] = KLD(5); LGK(5); SBAR(); p0 = MF(kf[0], qr[0], cinit); SBAR();
  kf[0] = KLD(6); LGK(5); SBAR(); p0 = MF(kf[1], qr[1], p0); dma(0); SBAR();
  kf[1] = KLD(7); LGK(5); SBAR(); p0 = MF(kf[2], qr[2], p0); SBAR();
  kf[2] = KLD(8); LGK(5); SBAR(); p0 = MF(kf[3], qr[3], p0); dma(1); SBAR();
  kf[3] = KLD(9); LGK(5); SBAR(); p0 = MF(kf[4], qr[4], p0); SBAR();
  kf[4] = KLD(10); LGK(5); SBAR(); p0 = MF(kf[5], qr[5], p0); dma(2); SBAR();
  kf[5] = KLD(11); LGK(5); SBAR(); p0 = MF(kf[0], qr[6], p0); SBAR();
  kf[0] = KLD(12); LGK(5); SBAR(); p0 = MF(kf[1], qr[7], p0); dma(3); SBAR();
  kf[1] = KLD(13); LGK(5); SBAR(); p0 = MF(kf[2], qr[8], p0); SBAR();
  kf[2] = KLD(14); LGK(5); SBAR(); p0 = MF(kf[3], qr[9], p0); dma(4); SBAR();
  kf[3] = KLD(15); LGK(5); SBAR(); p0 = MF(kf[4], qr[10], p0); SBAR();
  kf[4] = KLD(16); LGK(5); SBAR(); p0 = MF(kf[5], qr[11], p0); SBAR();
  kf[5] = KLD(17); LGK(5); SBAR(); p1 = MF(kf[0], qr[0], cinit); SBAR();
  kf[0] = KLD(18); LGK(5); SBAR(); p1 = MF(kf[1], qr[1], p1); SBAR();
  kf[1] = KLD(19); LGK(5); SBAR(); p1 = MF(kf[2], qr[2], p1); EX(p0, 0); EX(p0, 1); SBAR();
  kf[2] = KLD(20); LGK(5); SBAR(); p1 = MF(kf[3], qr[3], p1); EX(p0, 2); EX(p0, 3); SBAR();
  kf[3] = KLD(21); LGK(5); SBAR(); p1 = MF(kf[4], qr[4], p1); EX(p0, 4); EX(p0, 5); SBAR();
  kf[4] = KLD(22); LGK(5); SBAR(); p1 = MF(kf[5], qr[5], p1); EX(p0, 6); EX(p0, 7); SBAR();
  kf[5] = KLD(23); LGK(5); SBAR(); p1 = MF(kf[0], qr[6], p1); EX(p0, 8); EX(p0, 9); SBAR();
  LGK(4); SBAR(); p1 = MF(kf[1], qr[7], p1); EX(p0, 10); EX(p0, 11); SBAR();
  LGK(3); SBAR(); p1 = MF(kf[2], qr[8], p1); EX(p0, 12); EX(p0, 13); SBAR();
  LGK(2); SBAR(); p1 = MF(kf[3], qr[9], p1); EX(p0, 14); EX(p0, 15); SBAR();
  VRD(v0, 0, 0); LGK(5); SBAR(); p1 = MF(kf[4], qr[10], p1); PK4(p0, 0, pa0); SBAR();
  VRD(v1, 1, 0); LGK(8); SBAR(); p1 = MF(kf[5], qr[11], p1); PK4(p0, 8, pa1); SBAR();
#undef KLD
  VRD(v2, 2, 0); LGK(8); SBAR(); o[0] = MF(pa0, PKV(v0[0], v0[1]), o[0]); o[0] = MF(pa1, PKV(v0[2], v0[3]), o[0]);
  EX(p1, 0); EX(p1, 1); EX(p1, 2); EX(p1, 3); EX(p1, 4); EX(p1, 5); SBAR();
  VRD(v0, 3, 0); LGK(8); SBAR(); o[1] = MF(pa0, PKV(v1[0], v1[1]), o[1]); o[1] = MF(pa1, PKV(v1[2], v1[3]), o[1]);
  EX(p1, 6); EX(p1, 7); EX(p1, 8); EX(p1, 9); EX(p1, 10); EX(p1, 11); SBAR();
  VRD(v1, 0, 1); LGK(8); SBAR(); o[2] = MF(pa0, PKV(v2[0], v2[1]), o[2]); o[2] = MF(pa1, PKV(v2[2], v2[3]), o[2]);
  EX(p1, 12); EX(p1, 13); EX(p1, 14); EX(p1, 15); PK4(p1, 0, pa2); SBAR();
  VRD(v2, 1, 1); LGK(8); SBAR(); o[3] = MF(pa0, PKV(v0[0], v0[1]), o[3]); o[3] = MF(pa1, PKV(v0[2], v0[3]), o[3]);
  PK4(p1, 8, pa3); SBAR();
  VRD(v0, 2, 1); LGK(8); SBAR(); o[0] = MF(pa2, PKV(v1[0], v1[1]), o[0]); o[0] = MF(pa3, PKV(v1[2], v1[3]), o[0]); SBAR();
  VRD(v1, 3, 1); LGK(8); SBAR(); o[1] = MF(pa2, PKV(v2[0], v2[1]), o[1]); o[1] = MF(pa3, PKV(v2[2], v2[3]), o[1]); SBAR();
  LGK(4); SBAR(); o[2] = MF(pa2, PKV(v0[0], v0[1]), o[2]); o[2] = MF(pa3, PKV(v0[2], v0[3]), o[2]); SBAR();
  LGK(0); SBAR(); o[3] = MF(pa2, PKV(v1[0], v1[1]), o[3]); o[3] = MF(pa3, PKV(v1[2], v1[3]), o[3]); SBAR();
}
#undef LGK
#undef VRD
#undef PKV
constexpr int RING = 3, LI_OFF = RING * (SHM_V + SHM_K);
DEV void attn_unit(const bf16_t* __restrict__ Qb, const bf16_t* __restrict__ Kh, const bf16_t* __restrict__ Vh, bf16_t* __restrict__ Ob, int seq, LAS unsigned char* ldsl, int wv, float negUC) {
  char* lds = (char*)ldsl;
  const int tid = otid(wv), wid = tid >> 6, lane = tid & 63, r32 = lane & 31, hi = lane >> 5;
  char* V_lds = lds; char* K_lds = lds + RING * SHM_V;
  float l_reg = 0; f32x16 o[4] = {}; bf16x8 qr[12];
  const bf16_t* Qw = Qb + (long)(wid * QBLK + r32) * LDQ + hi * 8;
#pragma unroll
  for (int d0 = 0; d0 < 12; ++d0) qr[d0] = *reinterpret_cast<const bf16x8*>(Qw + d0 * 16);
  unsigned kgo[3], vgo[2];
#pragma unroll
  for (int i = 0; i < 3; ++i) { const int q = tid + 512 * i, row = q / 24, cc = q - row * 24; kgo[i] = (unsigned)(row * LDKK * 2 + ((cc * 16) ^ (((row >> 1) & 7) << 4))); }
#pragma unroll
  for (int i = 0; i < 2; ++i) { const int q = tid + 512 * i, sub = q >> 5, w = q & 31, kk = (sub >> 2) * 8 + (w >> 2), k = (kk & ~0xC) | ((kk & 4) << 1) | ((kk & 8) >> 1), c = (sub & 3) * 32 + (w & 3) * 8;
    vgo[i] = (unsigned)((k * LDKV + c) * 2); }
  const int vb0 = (int)(uintptr_t)V_lds + v_rd_base(lane);
  int kb[4];
#pragma unroll
  for (int i = 0; i < 4; ++i) kb[i] = r32 * 384 + ((i * 32 + hi * 16) ^ (((r32 >> 1) & 7) << 4));
  f32x16 cinit;
#pragma unroll
  for (int r = 0; r < 16; ++r) cinit[r] = negUC;
  const unsigned ldsw = (unsigned)wv * 1024u;
#define APIECE(SLOT, k0, I) do { if ((I) < 3) __builtin_amdgcn_global_load_lds((const unsigned*)((const char*)Kh + (size_t)(k0) * (LDKK * 2) + kgo[(I) < 3 ? (I) : 0]), (LAS unsigned*)(ldsl + RING * SHM_V + (SLOT) * SHM_K + ldsw + ((I) < 3 ? (I) : 0) * 8192), 16, 0, 0); \
    else __builtin_amdgcn_global_load_lds((const unsigned*)((const char*)Vh + (size_t)(k0) * (LDKV * 2) + vgo[(I) >= 3 ? (I) - 3 : 0]), (LAS unsigned*)(ldsl + (SLOT) * SHM_V + ldsw + ((I) >= 3 ? (I) - 3 : 0) * 8192), 16, 0, 0); } while (0)
#define ADMA(SLOT, k0) do { APIECE(SLOT, k0, 0); APIECE(SLOT, k0, 1); APIECE(SLOT, k0, 2); APIECE(SLOT, k0, 3); APIECE(SLOT, k0, 4); } while (0)
#define ATILE(SLOT, DSLOT, k0) att_tile(o, l_reg, (int)(uintptr_t)K_lds + (SLOT) * SHM_K, vb0 + (SLOT) * SHM_V, kb, qr, cinit, [&](int i) { switch (i) { case 0: APIECE(DSLOT, k0, 0); break; case 1: APIECE(DSLOT, k0, 1); break; case 2: APIECE(DSLOT, k0, 2); break; case 3: APIECE(DSLOT, k0, 3); break; default: APIECE(DSLOT, k0, 4); break; } })
#define ATILE0(SLOT) att_tile(o, l_reg, (int)(uintptr_t)K_lds + (SLOT) * SHM_K, vb0 + (SLOT) * SHM_V, kb, qr, cinit, [](int) {})
#define VM5() asm volatile("s_waitcnt vmcnt(5)" ::: "memory")
#define VM0() asm volatile("s_waitcnt vmcnt(0)" ::: "memory")
  const int NT = seq / KVBLK;
#define ABAR() do { SBAR(); __builtin_amdgcn_s_barrier(); SBAR(); } while (0)
  ADMA(0, 0); ADMA(1, KVBLK); VM5(); ABAR();
#pragma unroll 1
  for (int j = 0; j < NT - 3; j += 3) {
    ATILE(0, 2, (j + 2) * KVBLK); VM5(); ABAR();
    ATILE(1, 0, (j + 3) * KVBLK); VM5(); ABAR();
    ATILE(2, 1, (j + 4) * KVBLK); VM5(); ABAR();
  }
  ATILE(0, 2, (NT - 1) * KVBLK); VM5(); ABAR();
  ATILE0(1); VM0(); ABAR();
  ATILE0(2);
#undef ABAR
  l_reg = half_sum(l_reg);
  {
    const int t2 = otid(wv), wid2 = t2 >> 6, r2 = t2 & 31, hi2 = (t2 >> 5) & 1;
    float* li2 = (float*)(lds + LI_OFF) + wid2 * 64;
    if (hi2 == 0) li2[r2] = l_reg; asm volatile("s_waitcnt lgkmcnt(0)" ::: "memory");
    float rli[16];
#pragma unroll
    for (int r = 0; r < 16; ++r) rli[r] = __builtin_amdgcn_rcpf(li2[crow(r, hi2)]);
    bf16_t* Ow = Ob + (long)(wid2 * QBLK) * LDO;
#pragma unroll
    for (int r = 0; r < 16; ++r) { const int orow = crow(r, hi2);
#pragma unroll
      for (int d0 = 0; d0 < 4; ++d0) Ow[(long)orow * LDO + d0 * 32 + r2] = (bf16_t)f2bf(o[d0][r] * rli[r]); } }
  __syncthreads();
#undef ADMA
#undef APIECE
#undef ATILE
#undef ATILE0
#undef VM5
#undef VM0
}
}
DEV void p6_attention(const Params& p, LAS unsigned char* lds) {
  const bf16_t* qf = (const bf16_t*)(p.ws + A_QF); const bf16_t* kf = (const bf16_t*)(p.ws + A_KF); const bf16_t* vf = (const bf16_t*)(p.ws + A_VF); bf16_t* ymix = (bf16_t*)(p.ws + A_YMIX);
  const int G = gridDim.x, c = blockIdx.x;
  float negUC;
  { const int lane = otid(p.wv) & 63; float gq = 0.f, gk = 0.f;
#pragma unroll
    for (int i = 0; i < 3; ++i) { gq = fmaxf(gq, fabsf(p.qn_g[lane + 64 * i])); gk = fmaxf(gk, fabsf(p.kn_g[lane + 64 * i])); }
    gq = wave_max(gq); gk = wave_max(gk);
    negUC = -(13.856406460551018f * gq * gk) * 1.4426950408889634f * 1.0005f; }
  for (int i = 0;; ++i) {
    long u = (long)i * G + c; if (u >= 512) break;
    if (G == 256) { const int vcu = (c & 7) * 32 + (c >> 3); u = (long)i * 256 + vcu; }
    const int bh = (int)(u >> 5), qb = (int)(u & 31), b = bh >> 2, h = bh & 3;
    att::attn_unit(qf + ((size_t)(b * SEQ + qb * 256)) * 768 + h * QKD, kf + (size_t)b * SKV * 768 + h * QKD, vf + (size_t)b * SKV * 512 + h * VDIM,
                   ymix + ((size_t)(b * SEQ + qb * 256)) * 1024 + 512 + h * VDIM,
                   SKV,
                   lds, p.wv, negUC);
  }
}
DEV void p9_route(const Params& p, LAS unsigned char* lds, int ch0, int ch1, int chstep) {
  LAS int* lcnt = (LAS int*)lds; LAS int* lbase = lcnt + 32;
  const float* logit = (const float*)(p.ws + OFF_LOGIT); int* paire = (int*)(p.ws + OFF_PAIRE); int* pairr = (int*)(p.ws + OFF_PAIRR); float* pairg = (float*)(p.ws + OFF_PAIRG);
  int* rowtok = (int*)(p.ws + OFF_ROWTOK); int* cnt = (int*)(p.ws + OFF_CTL);
  const int tid = otid(p.wv);
  for (int ch = ch0; ch < ch1; ch += chstep) {
    if (tid < 32) lcnt[tid] = 0;
    __syncthreads();
    int se[4] = {0, 0, 0, 0}, lr[4] = {0, 0, 0, 0}; const int tok = ch * 128 + tid;
    if (tid < 128) {
      float lg[32];
#pragma unroll
      for (int q = 0; q < 8; ++q) { const f32x4 v = *(const f32x4*)(logit + (size_t)tok * 32 + q * 4), bb = *(const f32x4*)(p.router_b + q * 4); lg[q * 4] = v[0] + bb[0]; lg[q * 4 + 1] = v[1] + bb[1]; lg[q * 4 + 2] = v[2] + bb[2]; lg[q * 4 + 3] = v[3] + bb[3]; }
      float sv[4]; unsigned mask = 0u;
#pragma unroll
      for (int k = 0; k < 4; ++k) { float best = -3.0e38f; int bi = 0;
#pragma unroll
        for (int j = 0; j < 32; ++j) { const bool free_ = ((mask >> j) & 1u) == 0u; if (free_ && lg[j] > best) { best = lg[j]; bi = j; } }
        mask |= 1u << bi; se[k] = bi; sv[k] = best; }
      const float e1 = __expf(sv[1] - sv[0]), e2 = __expf(sv[2] - sv[0]), e3 = __expf(sv[3] - sv[0]); const float inv = 1.0f / (1.0f + e1 + e2 + e3);
      const f32x4 gt = {inv, e1 * inv, e2 * inv, e3 * inv}; *(f32x4*)(pairg + (size_t)tok * 4) = gt;
#pragma unroll
      for (int k = 0; k < 4; ++k) { paire[tok * 4 + k] = se[k]; lr[k] = __hip_atomic_fetch_add(&lcnt[se[k]], 1, __ATOMIC_RELAXED, __HIP_MEMORY_SCOPE_WORKGROUP); }
    }
    __syncthreads();
    if (tid < 32) lbase[tid] = atomicAdd(&cnt[tid], lcnt[tid]);
    __syncthreads();
    if (tid < 128) {
#pragma unroll
      for (int k = 0; k < 4; ++k) { const int rk = lbase[se[k]] + lr[k]; pairr[tok * 4 + k] = rk; rowtok[(size_t)se[k] * NTOK + rk] = tok; }
    }
    __syncthreads();
  }
}
DEV void build_group_table(const Params& p, LAS int* tab) {
  const int* cnt = (const int*)(p.ws + OFF_CTL);
  const int tid = otid(p.wv);
  if (tid < 32) tab[tid] = cnt[tid];
  __syncthreads();
  if (tid == 0) { int s = 0; for (int e = 0; e < 32; ++e) { tab[32 + e] = s; s += (tab[e] + 255) >> 8; } tab[64] = s; }
  __syncthreads();
}
DEV void p12_combine(const Params& p, const LAS int* tab, float* __restrict__ dst) {
  const bf16_t* __restrict__ ypair = (const bf16_t*)(p.ws + A_YPAIR); const int* __restrict__ paire = (const int*)(p.ws + OFF_PAIRE); const int* __restrict__ pairr = (const int*)(p.ws + OFF_PAIRR); const float* __restrict__ pairg = (const float*)(p.ws + OFF_PAIRG);
  const float* __restrict__ mod = (const float*)(p.ws + OFF_MOD);
  constexpr int RB = 2;
  const int tid = otid(p.wv), wid = tid >> 6, lane = tid & 63;
  for (int r0 = (blockIdx.x * 8 + wid) * RB; r0 < NTOK; r0 += gridDim.x * 8 * RB) {
    const float* g2 = mod + (size_t)(r0 >> 13) * 6144 + 5120;
    const bf16_t* yr[RB][4]; float gk[RB][4];
#pragma unroll
    for (int j = 0; j < RB; ++j)
#pragma unroll
      for (int k = 0; k < 4; ++k) { const int i = (r0 + j) * 4 + k; const int e = paire[i]; yr[j][k] = ypair + ((size_t)tab[32 + e] * 256 + pairr[i]) * ACLD; gk[j][k] = pairg[i]; }
    u32x2 w[RB][4][4]; f32x4 xv[RB][4];
#pragma unroll
    for (int j = 0; j < RB; ++j)
#pragma unroll
      for (int q = 0; q < 4; ++q) { const int col = q * 256 + lane * 4; xv[j][q] = *(const f32x4*)(p.out + (size_t)(r0 + j) * 1024 + col);
#pragma unroll
        for (int k = 0; k < 4; ++k) w[j][q][k] = *(const u32x2*)(yr[j][k] + col); }
#pragma unroll
    for (int j = 0; j < RB; ++j)
#pragma unroll
      for (int q = 0; q < 4; ++q) { const int col = q * 256 + lane * 4; f32x4 s = {0.f, 0.f, 0.f, 0.f};
#pragma unroll
        for (int k = 0; k < 4; ++k) { s[0] += gk[j][k] * bflo(w[j][q][k].x); s[1] += gk[j][k] * bfhi(w[j][q][k].x); s[2] += gk[j][k] * bflo(w[j][q][k].y); s[3] += gk[j][k] * bfhi(w[j][q][k].y); }
        const f32x4 gg = *(const f32x4*)(g2 + col); *(f32x4*)(dst + (size_t)(r0 + j) * 1024 + col) = xv[j][q] + gg * s; }
  }
}

#define XB_TMO      128
#define XB_XCNT(j)  (256  + 64 * (j))
#define XB_XSUB(j)  (1280 + 64 * (j))
#define XB_XGEN(j)  (2304 + 64 * (j))
#define XB_TOP      3328
#define XB_TOPGEN   3392
#define XCD_BAR_WORDS 3456
#define XB_SPIN_CAP (1u << 20)
DEV unsigned xb_ld(unsigned* p)              { return __hip_atomic_load(p, __ATOMIC_RELAXED, __HIP_MEMORY_SCOPE_AGENT); }
DEV unsigned xb_add(unsigned* p, unsigned v) { return __hip_atomic_fetch_add(p, v, __ATOMIC_RELAXED, __HIP_MEMORY_SCOPE_AGENT); }
DEV unsigned xb_xcc_id() { return (unsigned)__builtin_amdgcn_s_getreg((3 << 11) | 20) & 0xFu; }
#define XB_SPIN(cond, bar) do { unsigned _sp = 0; while (cond) { __builtin_amdgcn_s_sleep(1); \
    if ((++_sp & 255u) == 0u) { if (xb_ld(&(bar)[XB_TMO])) break; if (_sp > XB_SPIN_CAP) { atomicAdd(&(bar)[XB_TMO], 1u); break; } } } } while (0)
struct XcdBarrier { unsigned* bar; unsigned x; volatile LAS unsigned* st; int wv; };
DEV XcdBarrier xcd_barrier_post(unsigned* bar, volatile LAS unsigned* st, int wv) {
  XcdBarrier b; b.bar = bar; b.x = xb_xcc_id(); b.st = st; b.wv = wv;
  if (otid(wv) == 0) (void)xb_add(&bar[XB_XCNT(b.x)], 1u);
  return b;
}
DEV void xcd_barrier_complete(unsigned* bar, unsigned x, unsigned& nloc, unsigned& nx) {
  const unsigned G = gridDim.x * gridDim.y * gridDim.z;
  unsigned sum, cnt, mine, sp = 0u;
  for (;;) {
    sum = 0u; cnt = 0u; mine = 0u;
#pragma unroll
    for (unsigned j = 0; j < 16; ++j) { const unsigned c = xb_ld(&bar[XB_XCNT(j)]); sum += c; cnt += (c > 0u) ? 1u : 0u; mine = (j == x) ? c : mine; }
    if (sum == G) break;
    __builtin_amdgcn_s_sleep(1);
    if ((++sp & 255u) == 0u) { if (xb_ld(&bar[XB_TMO])) break; if (sp > XB_SPIN_CAP) { atomicAdd(&bar[XB_TMO], 1u); break; } }
  }
  nloc = mine > 0u ? mine : 1u; nx = cnt > 0u ? cnt : 1u;
}
DEV void xcd_barrier(const XcdBarrier& b) {
  asm volatile("s_waitcnt vmcnt(0)" ::: "memory");
  __syncthreads();
  if (otid(b.wv) == 0) {
    unsigned* bar = b.bar;
    __builtin_amdgcn_s_waitcnt(0);
    unsigned nloc = b.st[0], nx = b.st[1];
    if (nloc == 0u) { xcd_barrier_complete(bar, b.x, nloc, nx); b.st[0] = nloc; b.st[1] = nx; }
    const unsigned old = xb_add(&bar[XB_XSUB(b.x)], 1u);
    const unsigned gen = old / nloc;
    if (old + 1u == (gen + 1u) * nloc) {
      __builtin_amdgcn_fence(__ATOMIC_RELEASE, "agent");
      asm volatile("s_waitcnt vmcnt(0)" ::: "memory");
      const unsigned og = xb_add(&bar[XB_TOP], 1u);
      const unsigned tg = og / nx;
      if (og + 1u == (tg + 1u) * nx) xb_add(&bar[XB_TOPGEN], 1u);
      else XB_SPIN(xb_ld(&bar[XB_TOPGEN]) == tg, bar);
      __builtin_amdgcn_fence(__ATOMIC_ACQUIRE, "agent");
      xb_add(&bar[XB_XGEN(b.x)], 1u);
      asm volatile("s_waitcnt vmcnt(0)" ::: "memory");
    } else {
      XB_SPIN(xb_ld(&bar[XB_XGEN(b.x)]) == gen, bar);
      __builtin_amdgcn_fence(__ATOMIC_ACQUIRE, "agent");
      asm volatile("s_waitcnt vmcnt(0)" ::: "memory");
    }
  }
  __syncthreads();
}
#endif
extern __shared__ __attribute__((aligned(16))) unsigned char smem_raw[];
__global__ void __launch_bounds__(NTHR, 2) mk_fwd(Params p_in) {
#if defined(__HIP_DEVICE_COMPILE__)
  Params p = p_in; p.wv = __builtin_amdgcn_readfirstlane((int)(threadIdx.x >> 6));
  cg::grid_group grid = cg::this_grid();
  LAS unsigned char* lds = (LAS unsigned char*)smem_raw;
  const int G = gridDim.x, c = blockIdx.x;
  const float* mod = (const float*)(p.ws + OFF_MOD);
  volatile LAS unsigned* xst = (volatile LAS unsigned*)(lds + (LDS_BYTES - 64));
  { const int t0_ = otid(p.wv); if (t0_ < 4) xst[t0_] = 0u; }
  __syncthreads();
  const XcdBarrier xb = xcd_barrier_post((unsigned*)(p.ws + OFF_BAR), xst, p.wv);
  if (G == 256) {
    if (c < 128) p0_filters(p, lds, c, 128); else p0_mod(p, lds, c - 128, 128);
  } else { p0_mod(p, lds, c, G); p0_filters(p, lds, c, G); }
  p0_transposes(p, lds);
  xcd_barrier(xb);
  if (p.ws == nullptr) grid.sync();
  p0b_reduce(p, lds);
  xcd_barrier(xb);
  p1_ctx(p, lds);
  rows_norm_mod(p.x, p.norm1_g, mod, 0, 1024, (bf16_t*)(p.ws + A_H), p.wv);
  p1_spectrum(p, lds);
  xcd_barrier(xb);
  { DenseOrder S; S.init(NTOK, INCP, 1024, p.ws + OFF_WINT, G, c); EpiBf16 E{(bf16_t*)(p.ws + A_HCAT), HCLD}; gemm_phase(lds, p.ws + A_H, S, E, p.wv); }
  xcd_barrier(xb);
  p3_hyena_prep(p, lds);
  { DenseOrder S; S.init(NTOK, 768, 256, p.ws + OFF_WUQT, G, c, HCLD); EpiBf16 E{(bf16_t*)(p.ws + A_QRAW), 768}; gemm_phase(lds, (const bf16_t*)(p.ws + A_HCAT) + CQCOL, S, E, p.wv); }
  { DenseOrder S; S.init(NTOK, 1024, 128, p.ws + OFF_WUKVT, G, c, HCLD); EpiBf16 E{(bf16_t*)(p.ws + A_KVRAW), ACLD}; gemm_phase(lds, (const bf16_t*)(p.ws + A_HCAT) + KVCOL, S, E, p.wv); }
  xcd_barrier(xb);
  p5_qkv_final(p);
  p6_conv(p, lds);
  xcd_barrier(xb);
  p7_transpose(p, lds);
  p6_attention(p, lds);
  xcd_barrier(xb);
  { DenseOrder S; S.init(NTOK, 1024, 1024, p.ws + OFF_WOUTT, G, c); EpiResid E{p.x, p.out, mod}; gemm_phase(lds, p.ws + A_YMIX, S, E, p.wv); }
  xcd_barrier(xb);
  rows_norm_mod(p.out, p.norm2_g, mod, 3072, 4096, (bf16_t*)(p.ws + A_H2), p.wv);
  xcd_barrier(xb);
  { DenseOrder S; S.init(NTOK, 256, 1024, p.ws + OFF_WRT, G, c); EpiLogits E{(float*)(p.ws + OFF_LOGIT)}; gemm_phase(lds, p.ws + A_H2, S, E, p.wv);
    Unit u; for (int i = 0; S.next(i, u); ++i) p9_route(p, lds, 2 * u.pm, 2 * u.pm + 2, 1); }
  xcd_barrier(xb);
  LAS int* tab = (LAS int*)(lds + TAB_OFF);
  build_group_table(p, tab);
  { GroupedOrder<true> S; S.init(2048, 1024, p.ws + OFF_WGUT, tab, (const int*)(p.ws + OFF_ROWTOK), G, c); EpiGlu E{(bf16_t*)(p.ws + A_ACT), p.b_gu}; gemm_phase(lds, p.ws + A_H2, S, E, p.wv); }
  xcd_barrier(xb);
  { GroupedOrder<false> S; S.init(1024, 1024, p.ws + OFF_WDNT, tab, nullptr, G, c, ACLD); EpiDown E{(bf16_t*)(p.ws + A_YPAIR), p.b_down}; gemm_phase(lds, p.ws + A_ACT, S, E, p.wv); }
  xcd_barrier(xb);
  p12_combine(p, tab, p.out);
#endif
}

extern "C" void kernel_launch(void* const* d_in, const int* in_sizes, int n_in, void* d_out, int out_size, void* d_ws, size_t ws_size, hipStream_t stream) {
  static int grid_blocks = 0;
  if (!grid_blocks) {
    int dev = 0, cus = 0, per_cu = 0;
    if (n_in != 33 || ws_size < WS_NEED) { fprintf(stderr, "kernel_launch: unexpected n_in %d or ws_size %zu (need %zu)\n", n_in, ws_size, WS_NEED); return; }
    (void)hipGetDevice(&dev);
    (void)hipDeviceGetAttribute(&cus, hipDeviceAttributeMultiprocessorCount, dev);
    if (hipFuncSetAttribute((const void*)mk_fwd, hipFuncAttributeMaxDynamicSharedMemorySize, (int)LDS_BYTES) != hipSuccess) { fprintf(stderr, "kernel_launch: hipFuncSetAttribute failed\n"); return; }
    if (hipOccupancyMaxActiveBlocksPerMultiprocessor(&per_cu, (const void*)mk_fwd, NTHR, LDS_BYTES) != hipSuccess || per_cu < 1) { fprintf(stderr, "kernel_launch: occupancy query failed\n"); return; }
    grid_blocks = cus;
  }
  Params p{};
  const float** pp = (const float**)&p;
  for (int i = 0; i < 33; ++i) pp[i] = (const float*)d_in[i];
  p.out = (float*)d_out; p.ws = (unsigned char*)d_ws;
  (void)hipMemsetAsync(d_ws, 0, ZERO_BYTES, stream);
  void* args[] = {&p};
  hipError_t e = hipLaunchCooperativeKernel((void*)mk_fwd, dim3(grid_blocks), dim3(NTHR), args, LDS_BYTES, stream);
  if (e != hipSuccess) fprintf(stderr, "cooperative launch failed: %s (grid %d)\n", hipGetErrorString(e), grid_blocks);
}
```

```cpp
#include <hip/hip_runtime.h>
#include <hip/hip_cooperative_groups.h>
#include <cstdio>
#include <cstdint>
namespace cg = cooperative_groups;

#define LAS __attribute__((address_space(3)))
#define HD __host__ __device__ __forceinline__
#define DEV __device__ __forceinline__
typedef unsigned short bf16_t;
typedef short bf16x8 __attribute__((ext_vector_type(8)));
typedef short s16x4 __attribute__((ext_vector_type(4)));
typedef float f32x4 __attribute__((ext_vector_type(4)));
typedef float f32x2 __attribute__((ext_vector_type(2)));
typedef float f32x16 __attribute__((ext_vector_type(16)));
typedef unsigned u32x4 __attribute__((ext_vector_type(4)));
typedef unsigned u32x2 __attribute__((ext_vector_type(2)));

constexpr int NB = 4, SEQ = 8192, DM = 1024, NTOK = NB * SEQ, CTXL = 256, SKV = SEQ + CTXL;
constexpr int DHY = 512, HYC = 1536, QRANK = 256, KVRANK = 128, ROPED = 64, NOPED = 128, QKD = 192, VDIM = 128, NHEAD = 4;
constexpr int INC = 1984, INCP = 2048, CQCOL = 1536, KVCOL = 1792, PECOL = 1920;
#ifndef HCLD_PAD
#define HCLD_PAD 128
#endif
constexpr int ACLD = 1024 + 64;
constexpr int HCLD = INCP + HCLD_PAD;
constexpr int NEXP = 32, TOPK = 4;
constexpr int NPAIR = NTOK * TOPK, MAXROWS = NPAIR + NEXP * 256;
constexpr int NTHR = 512;
constexpr size_t LDS_BYTES = 153600;
constexpr float NORM_EPS = 1e-6f;
constexpr size_t MiB = 1048576;

constexpr size_t OFF_CTL = 0;
constexpr size_t OFF_BAR = 4096;
constexpr size_t CTL_BYTES = 32768;
constexpr size_t ZERO_BYTES = CTL_BYTES;
constexpr size_t OFF_MOD = 32768;
constexpr size_t OFF_WINT = 196608;
constexpr size_t OFF_WUQT = OFF_WINT + (size_t)INCP * DM * 2;
constexpr size_t OFF_WUKVT = OFF_WUQT + 768 * 256 * 2;
constexpr size_t OFF_WOUTT = OFF_WUKVT + 1024 * 256 * 2;
constexpr size_t OFF_WRT = OFF_WOUTT + (size_t)DM * DM * 2;
constexpr size_t OFF_WGUT = OFF_WRT + 256 * 1024 * 2;
constexpr size_t OFF_WDNT = OFF_WGUT + (size_t)NEXP * 2048 * 1024 * 2;
constexpr size_t OFF_PAIRE = OFF_WDNT + (size_t)NEXP * 1024 * 1024 * 2;
constexpr size_t OFF_PAIRR = OFF_PAIRE + (size_t)NPAIR * 4;
constexpr size_t OFF_PAIRG = OFF_PAIRR + (size_t)NPAIR * 4;
constexpr size_t OFF_ROWTOK = OFF_PAIRG + (size_t)NPAIR * 4;
constexpr size_t OFF_LOGIT = OFF_ROWTOK + (size_t)NEXP * NTOK * 4;
constexpr size_t OFF_MODPART = OFF_LOGIT + (size_t)NTOK * 32 * 4;
constexpr size_t OFF_L1PART = OFF_MODPART + (size_t)32 * 5 * 6144 * 4;
constexpr size_t OFF_BIG = OFF_L1PART + (size_t)256 * 2 * 512 * 4;
constexpr size_t A_H = OFF_BIG;
constexpr size_t A_YMIX = A_H;
constexpr size_t A_HCAT = OFF_BIG + 64 * MiB;
constexpr size_t A_QRAW = A_H;
constexpr size_t A_KVRAW = OFF_BIG + 200 * MiB;
constexpr size_t A_UT = OFF_BIG + 524 * MiB;
constexpr size_t A_X0T = OFF_BIG + 296 * MiB;
constexpr size_t A_HFILT = OFF_BIG + 328 * MiB;
constexpr size_t A_YT = A_HFILT;
constexpr size_t A_HSPEC = OFF_BIG + 360 * MiB;
constexpr size_t A_QF = OFF_BIG + 393 * MiB;
constexpr size_t A_KF = OFF_BIG + 441 * MiB;
constexpr size_t A_VF = OFF_BIG + 491 * MiB;
constexpr size_t A_ACT = OFF_BIG;
constexpr size_t A_YPAIR = OFF_BIG + 290 * MiB;
constexpr size_t A_H2F8 = OFF_BIG + 150 * MiB;
constexpr size_t A_H2 = A_YPAIR;
constexpr size_t WS_NEED = OFF_BIG + 590 * MiB;

struct Params {
  const float *x, *c, *ctx, *c_ctx, *mod_w, *mod_b, *norm1_g, *w_in, *hy_conv_w, *hy_conv_b, *f_w1, *f_b1, *f_w2, *f_b2, *f_w3, *f_b3, *f_w4, *f_freq, *hy_bias,
      *q_norm_g, *w_uq, *kv_norm_g, *w_ukv, *qn_g, *kn_g, *w_out, *norm2_g, *router_w, *router_b, *w_gu, *b_gu, *w_down, *b_down;
  float* out; unsigned char* ws;
  int wv, pad_;
};

DEV unsigned f2bf(float f) { unsigned u = __builtin_bit_cast(unsigned, f); return (u + 0x7fffu + ((u >> 16) & 1u)) >> 16; }
DEV unsigned pk2(float lo, float hi) { return f2bf(lo) | (f2bf(hi) << 16); }
DEV float bf2f(unsigned h) { return __builtin_bit_cast(float, h << 16); }
DEV float bflo(unsigned w) { return __builtin_bit_cast(float, w << 16); }
DEV float bfhi(unsigned w) { return __builtin_bit_cast(float, w & 0xffff0000u); }
DEV unsigned cvt_pk_bf16(float lo, float hi) { unsigned r; asm volatile("v_cvt_pk_bf16_f32 %0, %1, %2" : "=v"(r) : "v"(lo), "v"(hi)); return r; }
template <int O> DEV float swz_xor(float v) { return __builtin_bit_cast(float, __builtin_amdgcn_ds_swizzle(__builtin_bit_cast(int, v), (O << 10) | 0x1F)); }
DEV float half_sum(float v) { auto rr = __builtin_amdgcn_permlane32_swap(__float_as_uint(v), __float_as_uint(v), false, false); const unsigned a = rr[0], b = rr[1]; return __uint_as_float(a) + __uint_as_float(b); }
DEV float half_max(float v) { auto rr = __builtin_amdgcn_permlane32_swap(__float_as_uint(v), __float_as_uint(v), false, false); const unsigned a = rr[0], b = rr[1]; return fmaxf(__uint_as_float(a), __uint_as_float(b)); }
DEV float wave_sum(float v) { v += swz_xor<16>(v); v += swz_xor<8>(v); v += swz_xor<4>(v); v += swz_xor<2>(v); v += swz_xor<1>(v); return half_sum(v); }
DEV float wave_max(float v) { v = fmaxf(v, swz_xor<16>(v)); v = fmaxf(v, swz_xor<8>(v)); v = fmaxf(v, swz_xor<4>(v)); v = fmaxf(v, swz_xor<2>(v)); v = fmaxf(v, swz_xor<1>(v)); return half_max(v); }
DEV int otid(int wv) { int t; asm volatile("v_mbcnt_lo_u32_b32 %0, -1, 0\n\tv_mbcnt_hi_u32_b32 %0, -1, %0" : "=v"(t)); return t | (wv << 6); }
#if defined(__HIP_DEVICE_COMPILE__)
DEV void p0_mod(const Params& p, LAS unsigned char* lds, int first, int step) {
  LAS float* sv = (LAS float*)lds;
  float* part = (float*)(p.ws + OFF_MODPART);
  const int tid = otid(p.wv);
  for (int it = first; it < 256; it += step) {
    const int cgp = it & 7, kgp = it >> 3, k0 = kgp * 32, c0 = cgp * 768;
    if (tid < 160) { const int r = tid >> 5, k = k0 + (tid & 31); const float v = r < 4 ? p.c[r * 1024 + k] : p.c_ctx[k]; sv[tid] = v / (1.f + expf(-v)); }
    __syncthreads();
    const bool two = tid < 256; float w0[32], w1[32];
#pragma unroll
    for (int k = 0; k < 32; ++k) { w0[k] = p.mod_w[(size_t)(k0 + k) * 6144 + c0 + tid]; w1[k] = two ? p.mod_w[(size_t)(k0 + k) * 6144 + c0 + 512 + tid] : 0.f; }
    float a0[5] = {}, a1[5] = {};
#pragma unroll
    for (int k = 0; k < 32; ++k)
#pragma unroll
      for (int r = 0; r < 5; ++r) { const float s = sv[r * 32 + k]; a0[r] += s * w0[k]; a1[r] += s * w1[k]; }
    const float b0 = kgp == 0 ? p.mod_b[c0 + tid] : 0.f, b1 = (kgp == 0 && two) ? p.mod_b[c0 + 512 + tid] : 0.f;
#pragma unroll
    for (int r = 0; r < 5; ++r) { part[(size_t)(kgp * 5 + r) * 6144 + c0 + tid] = a0[r] + b0; if (two) part[(size_t)(kgp * 5 + r) * 6144 + c0 + 512 + tid] = a1[r] + b1; }
    __syncthreads();
  }
}

DEV void p0b_reduce(const Params& p, LAS unsigned char* lds) {
  const float* part = (const float*)(p.ws + OFF_MODPART); const float* l1part = (const float*)(p.ws + OFF_L1PART);
  float* mod = (float*)(p.ws + OFF_MOD); float* l1sum = (float*)(p.ws + OFF_CTL + 256);
  LAS float* red = (LAS float*)lds;
  const int tid = otid(p.wv), wid = tid >> 6, lane = tid & 63;
  for (int idx = blockIdx.x * NTHR + tid; idx < 5 * 6144; idx += gridDim.x * NTHR) { float v[32];
#pragma unroll
    for (int g = 0; g < 32; ++g) v[g] = part[(size_t)g * 5 * 6144 + idx];
    float s = 0.f;
#pragma unroll
    for (int g = 0; g < 32; ++g) s += v[g];
    mod[idx] = s; }
  for (int c0 = blockIdx.x * 2; c0 < 512; c0 += gridDim.x * 2) {
    const float s0 = wave_sum(l1part[(size_t)tid * 512 + c0]), s1 = wave_sum(l1part[(size_t)tid * 512 + c0 + 1]);
    if (lane == 0) { red[wid] = s0; red[8 + wid] = s1; }
    __syncthreads();
    if (tid < 2) { float s = 0.f;
#pragma unroll
      for (int w = 0; w < 8; ++w) s += red[tid * 8 + w];
      l1sum[c0 + tid] = s; }
    __syncthreads();
  }
}

#ifndef F8_G1
#define F8_G1 1
#endif
#ifndef F8_G2
#define F8_G2 1
#endif
#ifndef F8_Y
#define F8_Y 1
#endif
constexpr float Y8SCALE = 4.0f;
constexpr float W8SCALE = 64.0f, A8SCALE = 4.0f;
struct TItem { const float* src; bf16_t* dst; const float* kscale; int Ksrc, Nsrc, ldd, k0, n0, gu, f8; };
DEV TItem titem_decode(const Params& p, int it) {
  constexpr int S0 = 128, S1 = S0 + 12, S2 = S1 + 16, S3 = S2 + 64, S4 = S3 + 16, S5 = S4 + 4096;
  TItem t; t.gu = 0; t.f8 = 0; t.kscale = nullptr;
  if (it < S0) { t.src = p.w_in; t.dst = (bf16_t*)(p.ws + OFF_WINT); t.Ksrc = 1024; t.Nsrc = INC; t.ldd = 1024; t.k0 = (it >> 4) * 128; t.n0 = (it & 15) * 128; }
  else if (it < S1) { const int j = it - S0; t.src = p.w_uq; t.kscale = p.q_norm_g; t.dst = (bf16_t*)(p.ws + OFF_WUQT); t.Ksrc = 256; t.Nsrc = 768; t.ldd = 256; t.k0 = (j / 6) * 128; t.n0 = (j % 6) * 128; }
  else if (it < S2) { const int j = (it - S1) & 7; t.src = p.w_ukv; t.kscale = p.kv_norm_g; t.dst = (bf16_t*)(p.ws + OFF_WUKVT); t.Ksrc = 128; t.Nsrc = 1024; t.ldd = 128; t.k0 = 0; t.n0 = j * 128; }
  else if (it < S3) { const int j = it - S2; t.src = p.w_out; t.dst = (bf16_t*)(p.ws + OFF_WOUTT); t.Ksrc = 1024; t.Nsrc = 1024; t.ldd = 1024; t.k0 = (j >> 3) * 128; t.n0 = (j & 7) * 128; }
  else if (it < S4) { const int j = it - S3; t.src = p.router_w; t.dst = (bf16_t*)(p.ws + OFF_WRT); t.Ksrc = 1024; t.Nsrc = 32; t.ldd = 1024; t.k0 = (j >> 1) * 128; t.n0 = (j & 1) * 128; }
  else if (it < S5) { const int j = it - S4, e = j >> 7, r = j & 127; t.src = p.w_gu + (size_t)e * 1024 * 2048; t.dst = (bf16_t*)(p.ws + OFF_WGUT + (size_t)e * 2048 * 1024 * (F8_G1 ? 1 : 2)); t.Ksrc = 1024; t.Nsrc = 2048; t.ldd = 1024; t.k0 = (r >> 4) * 128; t.n0 = (r & 15) * 128; t.gu = 1; t.f8 = F8_G1; }
  else { const int j = it - S5, e = j >> 6, r = j & 63; t.src = p.w_down + (size_t)e * 1024 * 1024; t.dst = (bf16_t*)(p.ws + OFF_WDNT + (size_t)e * 1024 * 1024 * (F8_G2 ? 1 : 2)); t.Ksrc = 1024; t.Nsrc = 1024; t.ldd = 1024; t.k0 = (r >> 3) * 128; t.n0 = (r & 7) * 128; t.f8 = F8_G2; }
  return t;
}
constexpr int T_ITEMS = 128 + 12 + 16 + 64 + 16 + 4096 + 2048;
DEV void titem_load(const TItem& t, int tid, f32x4 (&va)[4], f32x4 (&vb)[4]) {
  const int rb = tid >> 5, c4 = (tid & 31) * 4; const bool okn = (t.n0 + c4) < t.Nsrc;
#pragma unroll
  for (int j = 0; j < 4; ++j) { const int k = t.f8 ? t.k0 + 4 * rb + 64 * (j >> 1) + 2 * (j & 1) : t.k0 + 2 * rb + 32 * j;
    va[j] = (okn && k < t.Ksrc) ? *(const f32x4*)(t.src + (size_t)k * t.Nsrc + t.n0 + c4) : (f32x4){0.f, 0.f, 0.f, 0.f};
    vb[j] = (okn && (k + 1) < t.Ksrc) ? *(const f32x4*)(t.src + (size_t)(k + 1) * t.Nsrc + t.n0 + c4) : (f32x4){0.f, 0.f, 0.f, 0.f};
    if (t.kscale) { const float s0 = k < t.Ksrc ? t.kscale[k] : 0.f, s1 = (k + 1) < t.Ksrc ? t.kscale[k + 1] : 0.f; va[j] = va[j] * s0; vb[j] = vb[j] * s1; } }
}
#define W8C(X) __builtin_amdgcn_fmed3f((X) * W8SCALE, -448.0f, 448.0f)
DEV void titem_process(const TItem& cur, int tid, LAS unsigned* tile, const f32x4 (&va)[4], const f32x4 (&vb)[4]) {
  const int rb = tid >> 5, c4 = (tid & 31) * 4;
  if (cur.f8) {
#pragma unroll
    for (int jp = 0; jp < 2; ++jp) { const int w = rb + 16 * jp;
#pragma unroll
      for (int e = 0; e < 4; ++e) { int pk = 0; pk = __builtin_amdgcn_cvt_pk_fp8_f32(W8C(va[2 * jp][e]), W8C(vb[2 * jp][e]), pk, false); pk = __builtin_amdgcn_cvt_pk_fp8_f32(W8C(va[2 * jp + 1][e]), W8C(vb[2 * jp + 1][e]), pk, true);
        tile[(c4 + e) * 68 + (w ^ ((((c4 + e) >> 3) & 3) << 2))] = (unsigned)pk; } }
    return; }
#pragma unroll
  for (int j = 0; j < 4; ++j) { const int w = rb + 16 * j;
#pragma unroll
    for (int e = 0; e < 4; ++e) tile[(c4 + e) * 68 + (w ^ ((((c4 + e) >> 3) & 3) << 2))] = pk2(va[j][e], vb[j][e]); }
}
DEV void titem_store(const TItem& cur, int tid, const LAS unsigned* tile) {
  const int n = tid >> 2, q = (tid & 3) * 16, ng = cur.n0 + n; int drow;
  if (cur.gu) { const int j = ng & 1023, up = ng >> 10; drow = ((j >> 7) << 8) + (up << 7) + (j & 127); } else drow = ng;
  const int sx = (n >> 3) & 3;
  if (cur.f8) {
    const int seg = (tid & 3) >> 1, c0 = (tid & 1) * 2; const LAS u32x4* srow8 = (const LAS u32x4*)(tile + n * 68 + seg * 16);
    unsigned char* d8 = (unsigned char*)cur.dst + (size_t)drow * cur.ldd + cur.k0 + seg * 64 + c0 * 16;
    const u32x4 w0 = srow8[c0 ^ sx], w1 = srow8[(c0 + 1) ^ sx]; ((u32x4*)d8)[0] = w0; ((u32x4*)d8)[1] = w1; return; }
  const LAS u32x4* srow = (const LAS u32x4*)(tile + n * 68 + q);
  u32x4* d = (u32x4*)(cur.dst + (size_t)drow * cur.ldd + cur.k0 + q * 2);
  const u32x4 w0 = srow[0 ^ sx], w1 = srow[1 ^ sx], w2 = srow[2 ^ sx], w3 = srow[3 ^ sx];
  d[0] = w0; d[1] = w1; d[2] = w2; d[3] = w3;
}
DEV void p0_transposes(const Params& p, LAS unsigned char* lds) {
  LAS unsigned* tile = (LAS unsigned*)lds;
  LAS int* q = (LAS int*)(lds + 36864);
  unsigned* tq = (unsigned*)(p.ws + OFF_CTL + 128);
  const int tid = otid(p.wv);
  if (tid == 0) { q[0] = (int)atomicAdd(tq, 1u); q[1] = (int)atomicAdd(tq, 1u); }
  __syncthreads();
  int itA = q[0], itB = q[1];
  if (itA >= T_ITEMS) return;
  TItem cA = titem_decode(p, itA), cB = cA; f32x4 vaA[4], vbA[4], vaB[4], vbB[4];
  titem_load(cA, tid, vaA, vbA);
  if (itB < T_ITEMS) { cB = titem_decode(p, itB); titem_load(cB, tid, vaB, vbB); }
  for (;;) {
    titem_process(cA, tid, tile, vaA, vbA); if (tid == 0) q[0] = (int)atomicAdd(tq, 1u); __syncthreads();
    const TItem dA = cA; const int nA = q[0]; if (nA < T_ITEMS) { cA = titem_decode(p, nA); titem_load(cA, tid, vaA, vbA); }
    titem_store(dA, tid, tile); __syncthreads();
    if (itB >= T_ITEMS) break;
    titem_process(cB, tid, tile, vaB, vbB); if (tid == 0) q[1] = (int)atomicAdd(tq, 1u); __syncthreads();
    const TItem dB = cB; const int nB = q[1]; if (nB < T_ITEMS) { cB = titem_decode(p, nB); titem_load(cB, tid, vaB, vbB); }
    titem_store(dB, tid, tile); __syncthreads();
    if (nA >= T_ITEMS) break;
    itA = nA; itB = nB;
  }
}

template <int KP, int KREAL> DEV void filt_layer(const LAS float* inT, const float* __restrict__ w, const float* __restrict__ bias, const float* __restrict__ freq, LAS float* outT, int wid, int lane) {
  const int mt = wid & 1, nt = wid >> 1, x = lane & 15, q = lane >> 4, j = nt * 16 + x;
  f32x4 acc = {0.f, 0.f, 0.f, 0.f};
#pragma unroll
  for (int kk = 0; kk < KP / 4; ++kk) { const int k = 4 * kk + q; const float a = inT[k * 33 + mt * 16 + x]; const float b = (k < KREAL) ? w[k * 64 + j] : 0.f;
    acc = __builtin_amdgcn_mfma_f32_16x16x4f32(a, b, acc, 0, 0, 0); }
  const float bj = bias[j], fj = freq[j];
#pragma unroll
  for (int r = 0; r < 4; ++r) outT[j * 33 + mt * 16 + q * 4 + r] = sinf(fj * (acc[r] + bj));
}
DEV void p0_filters(const Params& p, LAS unsigned char* lds, int first, int step) {
  LAS float* zsT = (LAS float*)lds;
  LAS float* haT = zsT + 36 * 33;
  LAS float* hbT = haT + 64 * 33;
  LAS float* hcT = hbT + 64 * 33;
  LAS float* ot = hcT + 64 * 33;
  float* hfilt = (float*)(p.ws + A_HFILT); float* l1part = (float*)(p.ws + OFF_L1PART);
  const int tid = otid(p.wv), wid = p.wv, lane = tid & 63, l31 = lane & 31, lh = lane >> 5;
  constexpr float MIN_DECAY = -15.350567286626973f, MAX_DECAY = -3.0701134573253946f;
  for (int tb = first; tb < 256; tb += step) {
    const int t0 = tb * 32;
    for (int i = tid; i < 36 * 32; i += NTHR) { const int j = i >> 5, tt = i & 31, t = t0 + tt; float val = 0.f;
      if (j == 0) val = (float)t * (1.0f / 8191.0f);
      else if (j < 33) { const int bnd = (j - 1) & 15; const float f = 1e-4f + (float)bnd * ((15.0f - 1e-4f) / 15.0f); const float wa = 6.283185307179586f * (float)t * (1.0f / 8192.0f); const float arg = f * wa; val = j <= 16 ? cosf(arg) : -sinf(arg); }
      zsT[j * 33 + tt] = val; }
    __syncthreads();
    filt_layer<36, 33>(zsT, p.f_w1, p.f_b1, p.f_freq, haT, wid, lane); __syncthreads();
    filt_layer<64, 64>(haT, p.f_w2, p.f_b2, p.f_freq, hbT, wid, lane); __syncthreads();
    filt_layer<64, 64>(hbT, p.f_w3, p.f_b3, p.f_freq, hcT, wid, lane); __syncthreads();
    float av[32];
#pragma unroll
    for (int kk = 0; kk < 32; ++kk) av[kk] = hcT[(2 * kk + lh) * 33 + l31];
#pragma unroll 1
    for (int dir = 0; dir < 2; ++dir) {
      const int cb = wid * 64;
      const float* __restrict__ wb = p.f_w4 + (size_t)lh * 1024 + dir * 512 + cb + l31;
      f32x16 d0, d1;
#pragma unroll
      for (int r = 0; r < 16; ++r) { d0[r] = 0.f; d1[r] = 0.f; }
#pragma unroll
      for (int kk = 0; kk < 32; ++kk) { const float b0 = wb[(size_t)kk * 2048], b1 = wb[(size_t)kk * 2048 + 32];
        d0 = __builtin_amdgcn_mfma_f32_32x32x2f32(av[kk], b0, d0, 0, 0, 0); d1 = __builtin_amdgcn_mfma_f32_32x32x2f32(av[kk], b1, d1, 0, 0, 0); }
#pragma unroll
      for (int u = 0; u < 2; ++u) { const int c = cb + u * 32 + l31; const float adelta = fabsf(MIN_DECAY + (float)c * ((MAX_DECAY - MIN_DECAY) / 511.0f)); float l1 = 0.f;
#pragma unroll
        for (int r = 0; r < 16; ++r) { const int tt = (r & 3) + 8 * (r >> 2) + 4 * lh; const float val = (u ? d1[r] : d0[r]) * expf(-((float)(t0 + tt) * (1.0f / 8191.0f)) * adelta);
          ot[tt * 513 + c] = val; l1 += fabsf(val); }
        l1 = half_sum(l1);
        if (lh == 0) l1part[(size_t)(tb * 2 + dir) * 512 + c] = l1; }
      __syncthreads();
      { const int tt = tid & 31, cg0 = tid >> 5;
#pragma unroll 4
        for (int cc = cg0; cc < 512; cc += 16) hfilt[((size_t)(dir * 512 + cc)) * 8192 + t0 + tt] = ot[tt * 513 + cc]; }
      __syncthreads();
    }
  }
}

DEV void p1_ctx(const Params& p, LAS unsigned char* lds, int first, int step) {
  LAS float* hcs = (LAS float*)lds;
  LAS float* prj = hcs + 4096;
  LAS float* lat = prj + 8 * 4 * 192;
  LAS float* cn = lat + 4 * 192;
  LAS float* kvs = cn + 4 * 128;
  const float* mod = (const float*)(p.ws + OFF_MOD) + 4 * 6144;
  bf16_t* kf = (bf16_t*)(p.ws + A_KF); bf16_t* vf = (bf16_t*)(p.ws + A_VF);
  const int tid = otid(p.wv), wid = tid >> 6, lane = tid & 63;
  for (int it = first; it < 256; it += step) {
    if (wid < 4) { const int r = it * 4 + wid; const float* xr = p.ctx + (size_t)r * 1024; f32x4 v[4]; float ss = 0.f;
#pragma unroll
      for (int q = 0; q < 4; ++q) { v[q] = *(const f32x4*)(xr + q * 256 + lane * 4); ss += v[q][0] * v[q][0] + v[q][1] * v[q][1] + v[q][2] * v[q][2] + v[q][3] * v[q][3]; }
      ss = wave_sum(ss); const float rs = rsqrtf(ss * (1.0f / 1024.0f) + NORM_EPS);
#pragma unroll
      for (int q = 0; q < 4; ++q)
#pragma unroll
        for (int j = 0; j < 4; ++j) { const int col = q * 256 + lane * 4 + j; hcs[wid * 1024 + col] = v[q][j] * rs * p.norm1_g[col] * (1.0f + mod[1024 + col]) + mod[col]; } }
    __syncthreads();
    { const int kp = wid; float a[3][4] = {}; const float* w = p.w_in + (size_t)(kp * 128) * INC + KVCOL + lane;
#pragma unroll 1
      for (int k0 = 0; k0 < 128; k0 += 8) { float wv[8][3];
#pragma unroll
        for (int u = 0; u < 8; ++u)
#pragma unroll
          for (int cgi = 0; cgi < 3; ++cgi) wv[u][cgi] = w[(size_t)(k0 + u) * INC + cgi * 64];
#pragma unroll
        for (int u = 0; u < 8; ++u)
#pragma unroll
          for (int r = 0; r < 4; ++r) { const float hv = hcs[r * 1024 + kp * 128 + k0 + u];
#pragma unroll
            for (int cgi = 0; cgi < 3; ++cgi) a[cgi][r] += hv * wv[u][cgi]; } }
#pragma unroll
      for (int cgi = 0; cgi < 3; ++cgi)
#pragma unroll
        for (int r = 0; r < 4; ++r) prj[(kp * 4 + r) * 192 + cgi * 64 + lane] = a[cgi][r]; }
    __syncthreads();
    for (int i = tid; i < 4 * 192; i += NTHR) { float s = 0.f;
#pragma unroll
      for (int kp = 0; kp < 8; ++kp) s += prj[kp * 768 + i];
      lat[i] = s; }
    __syncthreads();
    if (wid < 4) { const float a = lat[wid * 192 + lane], b = lat[wid * 192 + 64 + lane]; const float ss = wave_sum(a * a + b * b); const float rs = rsqrtf(ss * (1.0f / 128.0f) + NORM_EPS);
      cn[wid * 128 + lane] = a * rs * p.kv_norm_g[lane]; cn[wid * 128 + 64 + lane] = b * rs * p.kv_norm_g[64 + lane]; }
    __syncthreads();
    { float a[2][4] = {};
#pragma unroll 1
      for (int k0 = 0; k0 < 128; k0 += 16) { float w0[16], w1[16];
#pragma unroll
        for (int u = 0; u < 16; ++u) { w0[u] = p.w_ukv[(k0 + u) * 1024 + tid]; w1[u] = p.w_ukv[(k0 + u) * 1024 + 512 + tid]; }
#pragma unroll
        for (int u = 0; u < 16; ++u)
#pragma unroll
          for (int r = 0; r < 4; ++r) { const float cv = cn[r * 128 + k0 + u]; a[0][r] += cv * w0[u]; a[1][r] += cv * w1[u]; } }
#pragma unroll
      for (int r = 0; r < 4; ++r) { kvs[r * 1024 + tid] = a[0][r]; kvs[r * 1024 + 512 + tid] = a[1][r]; } }
    __syncthreads();
#pragma unroll 1
    for (int q = 0; q < 2; ++q) { const int pr = wid * 2 + q, r = pr >> 2, h = pr & 3; const int row = it * 4 + r, b = row >> 8, j = row & 255;
      const float e0 = kvs[r * 1024 + h * 256 + lane], e1 = kvs[r * 1024 + h * 256 + 64 + lane], e2 = lat[r * 192 + 128 + lane];
      const float ss = wave_sum(e0 * e0 + e1 * e1 + e2 * e2); const float rs = rsqrtf(ss * (1.0f / 192.0f) + NORM_EPS);
      bf16_t* kd = kf + ((size_t)(b * SKV + SEQ + j) * NHEAD + h) * QKD;
      kd[lane] = (bf16_t)f2bf(e0 * rs * p.kn_g[lane]); kd[64 + lane] = (bf16_t)f2bf(e1 * rs * p.kn_g[64 + lane]); kd[128 + lane] = (bf16_t)f2bf(e2 * rs * p.kn_g[128 + lane]);
      bf16_t* vd = vf + ((size_t)(b * SKV + SEQ + j) * NHEAD + h) * VDIM;
      vd[lane] = (bf16_t)f2bf(kvs[r * 1024 + h * 256 + 128 + lane]); vd[64 + lane] = (bf16_t)f2bf(kvs[r * 1024 + h * 256 + 192 + lane]); }
    __syncthreads();
  }
}

DEV void rows_norm_mod(const float* __restrict__ src, const float* __restrict__ g, const float* __restrict__ mod_shift_off0, int shift_off, int scale_off, bf16_t* __restrict__ dst, int wv, int blk, int nblk, unsigned char* __restrict__ dst8 = nullptr) {
  constexpr int RB = 4;
  const int tid = otid(wv), wid = tid >> 6, lane = tid & 63;
  for (int r0 = (blk * 8 + wid) * RB; r0 < NTOK; r0 += nblk * 8 * RB) {
    f32x4 v[RB][4];
#pragma unroll
    for (int j = 0; j < RB; ++j)
#pragma unroll
      for (int q = 0; q < 4; ++q) v[j][q] = *(const f32x4*)(src + (size_t)(r0 + j) * 1024 + q * 256 + lane * 4);
    const float* mrow = mod_shift_off0 + (size_t)(r0 >> 13) * 6144;
    f32x4 gg[4], sc[4], sh[4];
#pragma unroll
    for (int q = 0; q < 4; ++q) { const int col = q * 256 + lane * 4; gg[q] = *(const f32x4*)(g + col); sc[q] = *(const f32x4*)(mrow + scale_off + col); sh[q] = *(const f32x4*)(mrow + shift_off + col); }
#pragma unroll
    for (int j = 0; j < RB; ++j) {
      float ss = 0.f;
#pragma unroll
      for (int q = 0; q < 4; ++q) ss += v[j][q][0] * v[j][q][0] + v[j][q][1] * v[j][q][1] + v[j][q][2] * v[j][q][2] + v[j][q][3] * v[j][q][3];
      ss = wave_sum(ss); const float rs = rsqrtf(ss * (1.0f / 1024.0f) + NORM_EPS);
#pragma unroll
      for (int q = 0; q < 4; ++q) { float o[4];
#pragma unroll
        for (int e = 0; e < 4; ++e) o[e] = v[j][q][e] * rs * gg[q][e] * (1.0f + sc[q][e]) + sh[q][e];
        u32x2 w; w.x = pk2(o[0], o[1]); w.y = pk2(o[2], o[3]); *(u32x2*)(dst + (size_t)(r0 + j) * 1024 + q * 256 + lane * 4) = w;
        if (dst8) { float c8[4];
#pragma unroll
          for (int e = 0; e < 4; ++e) c8[e] = __builtin_amdgcn_fmed3f(o[e], -448.0f, 448.0f);
          int pk = 0; pk = __builtin_amdgcn_cvt_pk_fp8_f32(c8[0], c8[1], pk, false); pk = __builtin_amdgcn_cvt_pk_fp8_f32(c8[2], c8[3], pk, true); *(int*)(dst8 + (size_t)(r0 + j) * 1024 + q * 256 + lane * 4) = pk; } }
    }
  }
}
struct cpx { float x, y; };
HD cpx cmul(cpx a, cpx b) { return cpx{a.x * b.x - a.y * b.y, a.x * b.y + a.y * b.x}; }
HD cpx cadd(cpx a, cpx b) { return cpx{a.x + b.x, a.y + b.y}; }
HD cpx csub(cpx a, cpx b) { return cpx{a.x - b.x, a.y - b.y}; }
HD cpx cconj(cpx a) { return cpx{a.x, -a.y}; }
DEV cpx LDC(const LAS f32x2* a, int i) { const f32x2 v = a[i]; return cpx{v.x, v.y}; }
DEV void STC(LAS f32x2* a, int i, cpx v) { a[i] = (f32x2){v.x, v.y}; }
constexpr int FFT_N = 16384;
HD int fidx(int p) { return p + ((p >> 6) << 2); }
constexpr int FFT_LDS_ELEMS = FFT_N + (FFT_N >> 6) * 4;
HD int brev14(int k) { return (int)(__builtin_bitreverse32((unsigned)k) >> 18); }
HD cpx twid(float frac, float sign) { float s, c; sincospif(2.0f * frac, &s, &c); return cpx{c, sign * s}; }

template <bool INV> HD void r16(cpx (&v)[16], cpx w1f) {
  const float sg = INV ? 1.f : -1.f;
  const cpx w1 = INV ? cconj(w1f) : w1f, w2 = cmul(w1, w1), w4 = cmul(w2, w2), w8 = cmul(w4, w4);
  const float C16[8] = {1.f, 0.92387953251f, 0.70710678119f, 0.38268343236f, 0.f, -0.38268343236f, -0.70710678119f, -0.92387953251f};
  const float S16[8] = {0.f, 0.38268343236f, 0.70710678119f, 0.92387953251f, 1.f, 0.92387953251f, 0.70710678119f, 0.38268343236f};
  if (!INV) {
#pragma unroll
    for (int m = 0; m < 8; ++m) { cpx a = v[m], b = v[m + 8]; cpx tw = cmul(w1, cpx{C16[m], sg * S16[m]}); v[m] = cadd(a, b); v[m + 8] = cmul(csub(a, b), tw); }
#pragma unroll
    for (int g = 0; g < 16; g += 8)
#pragma unroll
      for (int m = 0; m < 4; ++m) { cpx a = v[g + m], b = v[g + m + 4]; cpx tw = cmul(w2, cpx{C16[2 * m], sg * S16[2 * m]}); v[g + m] = cadd(a, b); v[g + m + 4] = cmul(csub(a, b), tw); }
#pragma unroll
    for (int g = 0; g < 16; g += 4)
#pragma unroll
      for (int m = 0; m < 2; ++m) { cpx a = v[g + m], b = v[g + m + 2]; cpx tw = cmul(w4, cpx{C16[4 * m], sg * S16[4 * m]}); v[g + m] = cadd(a, b); v[g + m + 2] = cmul(csub(a, b), tw); }
#pragma unroll
    for (int g = 0; g < 16; g += 2) { cpx a = v[g], b = v[g + 1]; v[g] = cadd(a, b); v[g + 1] = cmul(csub(a, b), w8); }
  } else {
#pragma unroll
    for (int g = 0; g < 16; g += 2) { cpx a = v[g], b = cmul(v[g + 1], w8); v[g] = cadd(a, b); v[g + 1] = csub(a, b); }
#pragma unroll
    for (int g = 0; g < 16; g += 4)
#pragma unroll
      for (int m = 0; m < 2; ++m) { cpx tw = cmul(w4, cpx{C16[4 * m], sg * S16[4 * m]}); cpx a = v[g + m], b = cmul(v[g + m + 2], tw); v[g + m] = cadd(a, b); v[g + m + 2] = csub(a, b); }
#pragma unroll
    for (int g = 0; g < 16; g += 8)
#pragma unroll
      for (int m = 0; m < 4; ++m) { cpx tw = cmul(w2, cpx{C16[2 * m], sg * S16[2 * m]}); cpx a = v[g + m], b = cmul(v[g + m + 4], tw); v[g + m] = cadd(a, b); v[g + m + 4] = csub(a, b); }
#pragma unroll
    for (int m = 0; m < 8; ++m) { cpx tw = cmul(w1, cpx{C16[m], sg * S16[m]}); cpx a = v[m], b = cmul(v[m + 8], tw); v[m] = cadd(a, b); v[m + 8] = csub(a, b); }
  }
}
template <bool INV, int LOGS, class ARR> HD void fft_pass16(ARR fz, int tid) {
  constexpr int stride = 1 << LOGS;
#pragma unroll 1
  for (int q = 0; q < 2; ++q) {
    const int bf = tid + q * 512;
    const int i0p = bf & (stride - 1), blk = bf >> LOGS;
    const int i0 = blk * (16 * stride) + i0p;
    cpx v[16];
#pragma unroll
    for (int m = 0; m < 16; ++m) v[m] = LDC(fz, fidx(i0 + m * stride));
    r16<INV>(v, LDC(fz, FFT_LDS_ELEMS + (LOGS == 10 ? i0p : LOGS == 6 ? 1024 + i0p : 1088 + i0p)));
#pragma unroll
    for (int m = 0; m < 16; ++m) STC(fz, fidx(i0 + m * stride), v[m]);
  }
}
template <bool INV, class ARR> HD void fft_pass4(ARR fz, int tid) {
#pragma unroll 1
  for (int q = 0; q < 8; ++q) {
    const int i0 = (tid + q * 512) * 4;
    cpx v0 = LDC(fz, fidx(i0)), v1 = LDC(fz, fidx(i0 + 1)), v2 = LDC(fz, fidx(i0 + 2)), v3 = LDC(fz, fidx(i0 + 3));
    if (!INV) {
      cpx a0 = cadd(v0, v2), a2 = csub(v0, v2), a1 = cadd(v1, v3), t = csub(v1, v3); cpx a3 = cpx{t.y, -t.x};
      v0 = cadd(a0, a1); v1 = csub(a0, a1); v2 = cadd(a2, a3); v3 = csub(a2, a3);
    } else {
      cpx a0 = cadd(v0, v1), a1 = csub(v0, v1), a2 = cadd(v2, v3), a3 = csub(v2, v3);
      cpx b3 = cpx{-a3.y, a3.x};
      v0 = cadd(a0, a2); v2 = csub(a0, a2); v1 = cadd(a1, b3); v3 = csub(a1, b3);
    }
    STC(fz, fidx(i0), v0); STC(fz, fidx(i0 + 1), v1); STC(fz, fidx(i0 + 2), v2); STC(fz, fidx(i0 + 3), v3);
  }
}
DEV void fft_table(LAS f32x2* fz, int tid) { for (int k = tid; k < 1024; k += NTHR) STC(fz, FFT_LDS_ELEMS + k, twid((float)k * (1.0f / 16384.0f), -1.f));
  if (tid < 64) STC(fz, FFT_LDS_ELEMS + 1024 + tid, twid((float)(16 * tid) * (1.0f / 16384.0f), -1.f)); if (tid < 4) STC(fz, FFT_LDS_ELEMS + 1088 + tid, twid((float)(256 * tid) * (1.0f / 16384.0f), -1.f));
  __syncthreads(); }
DEV void fft_fwd(LAS f32x2* fz, int tid) {
  fft_pass16<false, 10>(fz, tid); __syncthreads(); fft_pass16<false, 6>(fz, tid); __syncthreads(); fft_pass16<false, 2>(fz, tid); __syncthreads(); fft_pass4<false>(fz, tid); __syncthreads();
}
DEV void fft_inv(LAS f32x2* fz, int tid) {
  fft_pass4<true>(fz, tid); __syncthreads(); fft_pass16<true, 2>(fz, tid); __syncthreads(); fft_pass16<true, 6>(fz, tid); __syncthreads(); fft_pass16<true, 10>(fz, tid); __syncthreads();
}

DEV void p1_spectrum(const Params& p, LAS unsigned char* lds, int first, int step, bool table) {
  LAS f32x2* fz = (LAS f32x2*)lds; const int tid = otid(p.wv);
  const float* hfilt = (const float*)(p.ws + A_HFILT); const float* l1sum = (const float*)(p.ws + OFF_CTL + 256); cpx* hspec = (cpx*)(p.ws + A_HSPEC);
  if (table) fft_table(fz, tid);
  LAS f32x2* fzt = fz + fidx(tid);
  for (int pr = first; pr < 256; pr += step) {
    const int c0 = 2 * pr, c1 = c0 + 1; const float i0 = 1.0f / l1sum[c0], i1 = 1.0f / l1sum[c1];
    const float* f0 = hfilt + (size_t)c0 * 8192; const float* f1 = hfilt + (size_t)c1 * 8192; const float* b0 = hfilt + (size_t)(512 + c0) * 8192; const float* b1 = hfilt + (size_t)(512 + c1) * 8192;
    { float a0[16], a1[16], c0v[16], c1v[16];
#pragma unroll
      for (int i = 0; i < 16; ++i) { const int n = tid + i * NTHR; a0[i] = f0[n]; a1[i] = f1[n]; const int m = 8192 - n; c0v[i] = n ? b0[m] : 0.f; c1v[i] = n ? b1[m] : 0.f; }
#pragma unroll
      for (int i = 0; i < 16; ++i) { STC(fzt, 544 * i, cpx{a0[i] * i0, a1[i] * i1}); STC(fzt + 8704, 544 * i, cpx{c0v[i] * i0, c1v[i] * i1}); } }
    __syncthreads();
    fft_fwd(fz, tid);
    for (int q = tid; q <= 8192; q += NTHR) { const int pz = q < 8192 ? 2 * q : 1; const int k = brev14(pz), kk = (FFT_N - k) & (FFT_N - 1); const cpx a = LDC(fz, fidx(pz)), b = cconj(LDC(fz, fidx(brev14(kk)))); const cpx s = cadd(a, b), d = csub(a, b); const float sc = 0.5f / (float)FFT_N;
      hspec[(size_t)c0 * 8193 + q] = cpx{s.x * sc, s.y * sc}; hspec[(size_t)c1 * 8193 + q] = cpx{d.y * sc, -d.x * sc}; }
    __syncthreads();
  }
}

DEV void p1_queue(const Params& p, LAS unsigned char* lds, const float* mod) {
  LAS int* qs = (LAS int*)(lds + LDS_BYTES - 128);
  unsigned* tq = (unsigned*)(p.ws + OFF_CTL + 132);
  const int tid = otid(p.wv);
  fft_table((LAS f32x2*)lds, tid);
  if (tid == 0) qs[0] = (int)atomicAdd(tq, 1u);
  __syncthreads();
  int it = qs[0];
  __syncthreads();
  while (it < 1024) {
    unsigned nx = 0; if (tid == 0) nx = atomicAdd(tq, 1u);
    const int idx = it >> 1;
    if (it & 1) { rows_norm_mod(p.x, p.norm1_g, mod, 0, 1024, (bf16_t*)(p.ws + A_H), p.wv, idx * 2, 1024); rows_norm_mod(p.x, p.norm1_g, mod, 0, 1024, (bf16_t*)(p.ws + A_H), p.wv, idx * 2 + 1, 1024); }
    else if (idx < 256) p1_spectrum(p, lds, idx, 1 << 20, false);
    else p1_ctx(p, lds, idx - 256, 1 << 20);
    if (tid == 0) qs[0] = (int)nx;
    __syncthreads();
    it = qs[0];
    __syncthreads();
  }
}

DEV void p6_conv(const Params& p, LAS unsigned char* lds) {
  LAS f32x2* fz = (LAS f32x2*)lds; const int tid = otid(p.wv);
  const float* __restrict__ uT = (const float*)(p.ws + A_UT); const bf16_t* __restrict__ x0T = (const bf16_t*)(p.ws + A_X0T); const cpx* __restrict__ hspec = (const cpx*)(p.ws + A_HSPEC); bf16_t* __restrict__ yT = (bf16_t*)(p.ws + A_YT);
  fft_table(fz, tid);
  LAS f32x2* fzt = fz + fidx(tid);
  float ua0[16], ua1[16];
  int job = blockIdx.x;
  if (job < 1024) { const float* u0 = uT + ((size_t)(job & 3) * 512 + 2 * (job >> 2)) * 8192 + tid;
#pragma unroll
    for (int i = 0; i < 16; ++i) { ua0[i] = u0[i * NTHR]; ua1[i] = u0[8192 + i * NTHR]; } }
  for (; job < 1024; job += gridDim.x) {
    const int pr = job >> 2, b = job & 3, c0 = 2 * pr, c1 = c0 + 1;
#pragma unroll
    for (int i = 0; i < 16; ++i) { STC(fzt, 544 * i, cpx{ua0[i], ua1[i]}); STC(fzt + 8704, 544 * i, cpx{0.f, 0.f}); }
    int tj = tid; asm volatile("" : "+v"(tj));
    cpx h0[17], h1[17];
    { const cpx* H0 = hspec + (size_t)c0 * 8193; const cpx* H1 = hspec + (size_t)c1 * 8193;
#pragma unroll
      for (int i = 0; i < 16; ++i) { h0[i] = H0[tj + i * NTHR]; h1[i] = H1[tj + i * NTHR]; }
      h0[16] = H0[8192]; h1[16] = H1[8192]; }
    __syncthreads();
    fft_fwd(fz, tid);
#pragma unroll
    for (int i = 0; i < 17; ++i) { const int q = tj + i * NTHR; if (i < 16 || tj == 0) { const int pz = i < 16 ? 2 * q : 1; const int k = brev14(pz), kk = (FFT_N - k) & (FFT_N - 1); const int p1 = fidx(pz), p2 = fidx(brev14(kk));
      const cpx a = LDC(fz, p1), bb = cconj(LDC(fz, p2)); const cpx s = cadd(a, bb), d = csub(a, bb); const cpx U0 = cpx{0.5f * s.x, 0.5f * s.y}, U1 = cpx{0.5f * d.y, -0.5f * d.x};
      const cpx Y0 = cmul(U0, h0[i]), Y1 = cmul(U1, h1[i]);
      STC(fz, p1, cpx{Y0.x - Y1.y, Y0.y + Y1.x}); STC(fz, p2, cpx{Y0.x + Y1.y, -Y0.y + Y1.x}); } }
    unsigned xa[16], xb[16]; float na0[16], na1[16];
    { const bf16_t* x00 = x0T + ((size_t)b * 512 + c0) * 8192 + tj;
#pragma unroll
      for (int i = 0; i < 16; ++i) { xa[i] = x00[i * NTHR]; xb[i] = x00[8192 + i * NTHR]; }
      const int nj = job + gridDim.x; const int njc = nj < 1024 ? nj : job; const float* u0n = uT + ((size_t)(njc & 3) * 512 + 2 * (njc >> 2)) * 8192 + tj;
#pragma unroll
      for (int i = 0; i < 16; ++i) { na0[i] = u0n[i * NTHR]; na1[i] = u0n[8192 + i * NTHR]; } }
    __syncthreads();
    fft_inv(fz, tid);
    { const float bi0 = p.hy_bias[c0], bi1 = p.hy_bias[c1]; bf16_t* y0 = yT + ((size_t)b * 512 + c0) * 8192 + tj; bf16_t* y1 = y0 + 8192;
#pragma unroll
      for (int i = 0; i < 16; ++i) { const cpx v = LDC(fzt, 544 * i); y0[i * NTHR] = (bf16_t)f2bf((v.x + ua0[i] * bi0) * bf2f(xa[i])); y1[i * NTHR] = (bf16_t)f2bf((v.y + ua1[i] * bi1) * bf2f(xb[i])); } }
#pragma unroll
    for (int i = 0; i < 16; ++i) { ua0[i] = na0[i]; ua1[i] = na1[i]; }
    __syncthreads();
  }
}

DEV void p3_hyena_prep(const Params& p, LAS unsigned char* lds) {
  constexpr int RS = 3 * 256 + 2;
  LAS bf16_t* raw = (LAS bf16_t*)lds;
  LAS f32x4* wtab = (LAS f32x4*)(lds + 106496);
  const bf16_t* __restrict__ hcat = (const bf16_t*)(p.ws + A_HCAT); float* __restrict__ uT = (float*)(p.ws + A_UT); bf16_t* __restrict__ x0T = (bf16_t*)(p.ws + A_X0T);
  const int tid = otid(p.wv);
  int it = blockIdx.x; if (it >= 1024) return;
  const int step = gridDim.x;
  if ((step & 1) == 0) { const int cb0 = (it & 1) * 256;
    for (int i = tid; i < 768; i += NTHR) { const int g = i >> 8, cl = i & 255, col = g * 512 + cb0 + cl; wtab[i] = (f32x4){p.hy_conv_w[col], p.hy_conv_w[HYC + col], p.hy_conv_w[2 * HYC + col], p.hy_conv_b[col]}; } }
  u32x4 w[13];
#define P3_LOAD(IT) do { const int cgp_ = (IT) & 1, tt_ = ((IT) >> 1) & 127, b_ = (IT) >> 8, t0_ = tt_ * 64, cb_ = cgp_ * 256; \
    _Pragma("unroll") for (int i = 0; i < 13; ++i) { const int q = tid + i * NTHR; const int rr = q / 96, r2 = q - rr * 96, g = r2 >> 5, ch8 = (r2 & 31) * 8; const int t = t0_ - 1 + rr; \
      w[i] = (u32x4){0u, 0u, 0u, 0u}; if (q < 6336 && t >= 0 && t < SEQ) w[i] = *(const u32x4*)(hcat + ((size_t)(b_ * SEQ + t)) * HCLD + g * 512 + cb_ + ch8); } } while (0)
  P3_LOAD(it);
  for (;;) {
    const int cgp = it & 1, tt = (it >> 1) & 127, b = it >> 8, t0 = tt * 64, cb = cgp * 256;
#pragma unroll
    for (int i = 0; i < 13; ++i) { const int q = tid + i * NTHR; if (q < 6336) { const int rr = q / 96, r2 = q - rr * 96, g = r2 >> 5, ch8 = (r2 & 31) * 8;
      LAS unsigned* d = (LAS unsigned*)(raw + rr * RS + g * 256 + ch8); d[0] = w[i].x; d[1] = w[i].y; d[2] = w[i].z; d[3] = w[i].w; } }
    if (step & 1) { for (int i = tid; i < 768; i += NTHR) { const int g = i >> 8, cl = i & 255, col = g * 512 + cb + cl; wtab[i] = (f32x4){p.hy_conv_w[col], p.hy_conv_w[HYC + col], p.hy_conv_w[2 * HYC + col], p.hy_conv_b[col]}; } }
    __syncthreads();
    const int nit = it + step;
    if (nit < 1024) P3_LOAD(nit);
    { const int t = tid & 63, cq = tid >> 6;
#pragma unroll 2
      for (int j = 0; j < 32; ++j) { const int cl = cq * 32 + j, c = cb + cl; float cv[3];
#pragma unroll
        for (int g = 0; g < 3; ++g) { const f32x4 wq = wtab[g * 256 + cl];
          cv[g] = bf2f(raw[t * RS + g * 256 + cl]) * wq[0] + bf2f(raw[(t + 1) * RS + g * 256 + cl]) * wq[1] + bf2f(raw[(t + 2) * RS + g * 256 + cl]) * wq[2] + wq[3]; }
        const size_t o = ((size_t)b * 512 + c) * 8192 + t0 + t; uT[o] = cv[1] * cv[2]; x0T[o] = (bf16_t)f2bf(cv[0]); } }
    __syncthreads();
    if (nit >= 1024) break;
    it = nit;
  }
#undef P3_LOAD
}
DEV void p7_transpose(const Params& p, LAS unsigned char* lds) {
  LAS bf16_t* tl = (LAS bf16_t*)lds;
  const bf16_t* yT = (const bf16_t*)(p.ws + A_YT); bf16_t* ymix = (bf16_t*)(p.ws + A_YMIX);
  const int tid = otid(p.wv);
  for (int it = blockIdx.x; it < 4096; it += gridDim.x) {
    const int cgp = it & 7, tt = (it >> 3) & 127, b = it >> 10, t0 = tt * 64, cb = cgp * 64;
    { const int c = tid >> 3, t8 = (tid & 7) * 8; const u32x4 w = *(const u32x4*)(yT + ((size_t)b * 512 + cb + c) * 8192 + t0 + t8);
      LAS unsigned* d = (LAS unsigned*)(tl + c * 66 + t8); d[0] = w.x; d[1] = w.y; d[2] = w.z; d[3] = w.w; }
    __syncthreads();
    { const int t = tid >> 3, c8 = (tid & 7) * 8; unsigned short e[8];
#pragma unroll
      for (int j = 0; j < 8; ++j) e[j] = tl[(c8 + j) * 66 + t];
      u32x4 w; w.x = e[0] | ((unsigned)e[1] << 16); w.y = e[2] | ((unsigned)e[3] << 16); w.z = e[4] | ((unsigned)e[5] << 16); w.w = e[6] | ((unsigned)e[7] << 16);
      *(u32x4*)(ymix + ((size_t)(b * SEQ + t0 + t)) * 1024 + cb + c8) = w; }
    __syncthreads();
  }
}
constexpr int BM = 256, BK = 64, HALF = 128, HTB = HALF * BK * 2, RING_BYTES = 8 * HTB, NXCD = 8, WGM = 8;
constexpr int TAB_OFF = RING_BYTES;
HD int lds_byte(int r, int c) { const int st = (r >> 4) * 2 + (c >> 5), rr = r & 15, cc = c & 31, ob = rr * 64 + cc * 2; return st * 1024 + (ob ^ (((ob >> 9) & 1) << 5)); }
HD void stage_rc(int b, int& R, int& C) { const int st = b / 1024, sb = b % 1024, swz = sb ^ (((sb >> 9) & 1) << 5); R = (st >> 1) * 16 + swz / 64; C = (st & 1) * 32 + (swz % 64) / 2; }
HD int perm32(int rho) { const int n = rho >> 4, i = rho & 15; return 8 * (i >> 2) + 4 * n + (i & 3); }

struct Unit { int pm, pn, e, mt; };

struct DenseOrder {
  static constexpr bool PREFETCH_ROWS = false;
  int nM, nN, nwg, G, c, K; unsigned lda; const char* Bt;
  DEV void init(int M, int N, int K_, const void* Bt_, int G_, int c_, int lda_elems = 0) { nM = M / BM; nN = N / BM; nwg = nM * nN; G = G_; c = c_; K = K_; Bt = (const char*)Bt_; lda = (unsigned)(lda_elems ? lda_elems : K_) * 2u; }
  DEV bool next(int i, Unit& u) const {
    const long L = (long)i * G + c; if (L >= nwg) return false;
    int wgid = (int)L; { const int q = nwg / NXCD, r = nwg % NXCD, xcd = wgid % NXCD, off = wgid / NXCD; wgid = (xcd < r ? xcd * (q + 1) : r * (q + 1) + (xcd - r) * q) + off; }
    const int nig = WGM * nN, gid = wgid / nig, fm = gid * WGM, gsz = (nM - fm) < WGM ? (nM - fm) : WGM;
    u.pm = fm + ((wgid % nig) % gsz); u.pn = (wgid % nig) / gsz; u.e = 0; u.mt = 0; return true;
  }
  DEV const char* bptr(const Unit& u) const { return Bt + (size_t)u.pn * BM * K * 2; }
  DEV unsigned arow_off(const Unit& u, int r) const { return (unsigned)(u.pm * BM + r) * lda; }
};
template <bool GATHER> struct GroupedOrder {
  static constexpr bool PREFETCH_ROWS = GATHER;
  int nN, G, c, K, total; unsigned lda; const char* Bt; size_t bstride; const LAS int* cnt; const LAS int* tpref; const int* rowtok; const LAS int* utab;
  DEV void init(int N, int K_, const void* Bt_, LAS int* tab, const int* rowtok_, int G_, int c_, int wv, int lda_elems = 0) { lda = (unsigned)(lda_elems ? lda_elems : K_) * 2u; nN = N / BM; K = K_; Bt = (const char*)Bt_; bstride = (size_t)N * K_ * 2; cnt = tab; tpref = tab + 32; rowtok = rowtok_; G = G_; c = c_; total = tab[64] * nN;
    LAS int* ut = tab + 128; utab = ut; const int i = otid(wv);
    if (i < 32) { const int gx = G >> 3; const long L = (G & 7) ? (long)i * G + c : (long)i * G + (c & 7) * gx + (c >> 3); int e = -1, mt = 0, pn = 0, pm = 0;
      if (L < total) { e = 0; while (e < 31 && (int)L >= tpref[e + 1] * nN) ++e; const int idx = (int)L - tpref[e] * nN; mt = idx / nN; pn = idx - mt * nN; pm = tpref[e] + mt; }
      ut[4 * i] = e; ut[4 * i + 1] = mt; ut[4 * i + 2] = pn; ut[4 * i + 3] = pm; }
    __syncthreads(); }
  DEV bool next(int i, Unit& u) const {
    if (i >= 32) return false;
    const int e = utab[4 * i]; if (e < 0) return false;
    u.e = e; u.mt = utab[4 * i + 1]; u.pn = utab[4 * i + 2]; u.pm = utab[4 * i + 3]; return true;
  }
  DEV const char* bptr(const Unit& u) const { return Bt + (size_t)u.e * bstride + (size_t)u.pn * BM * K * 2; }
  DEV unsigned arow_off(const Unit& u, int r) const {
    if (GATHER) { const int j = u.mt * BM + r; const int tok = j < cnt[u.e] ? rowtok[u.e * NTOK + j] : 0; return (unsigned)tok * lda; }
    else return (unsigned)(u.pm * BM + r) * lda;
  }
};

struct EpiBf16 {
  static constexpr bool PERM = true;
  bf16_t* O; int ldc;
  DEV void operator()(const f32x4 (&acc)[2][2][4][2], const Unit& u, int wr, int wc, int fr, int fq) const {
    const int row0 = u.pm * BM + wr * 64 + fr, col0 = u.pn * BM + wc * 32 + 8 * fq;
#pragma unroll
    for (int ai = 0; ai < 2; ++ai)
#pragma unroll
      for (int m = 0; m < 4; ++m) { bf16_t* rowp = O + (size_t)(row0 + ai * HALF + m * 16) * ldc + col0;
#pragma unroll
        for (int bj = 0; bj < 2; ++bj) { const f32x4 v0 = acc[ai][bj][m][0], v1 = acc[ai][bj][m][1]; u32x4 w; w.x = cvt_pk_bf16(v0[0], v0[1]); w.y = cvt_pk_bf16(v0[2], v0[3]); w.z = cvt_pk_bf16(v1[0], v1[1]); w.w = cvt_pk_bf16(v1[2], v1[3]);
          *(u32x4*)(rowp + bj * HALF) = w;
          } }
  }
};
struct EpiResid {
  static constexpr bool PERM = false;
  const float* x; float* out; const float* mod;
  DEV void operator()(const f32x4 (&acc)[2][2][4][2], const Unit& u, int wr, int wc, int fr, int fq) const {
    const int row0 = u.pm * BM + wr * 64 + fr, col0 = u.pn * BM + wc * 32 + 4 * fq; const float* g = mod + (size_t)(row0 >> 13) * 6144 + 2048;
    f32x4 gv[2][2];
#pragma unroll
    for (int bj = 0; bj < 2; ++bj)
#pragma unroll
      for (int n = 0; n < 2; ++n) gv[bj][n] = *(const f32x4*)(g + col0 + bj * HALF + n * 16);
#pragma unroll
    for (int ai = 0; ai < 2; ++ai)
#pragma unroll
      for (int m = 0; m < 4; ++m) { const size_t ro = (size_t)(row0 + ai * HALF + m * 16) * 1024 + col0;
#pragma unroll
        for (int bj = 0; bj < 2; ++bj)
#pragma unroll
          for (int n = 0; n < 2; ++n) { const f32x4 xv = *(const f32x4*)(x + ro + bj * HALF + n * 16); *(f32x4*)(out + ro + bj * HALF + n * 16) = xv + gv[bj][n] * acc[ai][bj][m][n]; } }
  }
};
struct EpiLogits {
  static constexpr bool PERM = false;
  float* L;
  DEV void operator()(const f32x4 (&acc)[2][2][4][2], const Unit& u, int wr, int wc, int fr, int fq) const {
    if (wc != 0) return;
    const int row0 = u.pm * BM + wr * 64 + fr;
#pragma unroll
    for (int ai = 0; ai < 2; ++ai)
#pragma unroll
      for (int m = 0; m < 4; ++m)
#pragma unroll
        for (int n = 0; n < 2; ++n) *(f32x4*)(L + (size_t)(row0 + ai * HALF + m * 16) * 32 + n * 16 + 4 * fq) = acc[ai][0][m][n];
  }
};
template <bool IN8, bool OUT8> struct EpiGluT {
  static constexpr bool PERM = true;
  bf16_t* O; const float* b_gu;
  DEV void operator()(const f32x4 (&acc)[2][2][4][2], const Unit& u, int wr, int wc, int fr, int fq) const {
    const int row0 = u.pm * BM + wr * 64 + fr, j0 = u.pn * HALF + wc * 32 + 8 * fq; const float* bg = b_gu + (size_t)u.e * 2048 + j0;
    const f32x4 bg0 = *(const f32x4*)(bg), bg1 = *(const f32x4*)(bg + 4), bu0 = *(const f32x4*)(bg + 1024), bu1 = *(const f32x4*)(bg + 1028);
    constexpr float ISC = IN8 ? 1.0f / W8SCALE : 1.0f;
#pragma unroll
    for (int ai = 0; ai < 2; ++ai)
#pragma unroll
      for (int m = 0; m < 4; ++m) { f32x4 o[2];
#pragma unroll
        for (int n = 0; n < 2; ++n) { f32x4 gt = acc[ai][0][m][n] * ISC + (n ? bg1 : bg0), up = acc[ai][1][m][n] * ISC + (n ? bu1 : bu0), e, r;
#pragma unroll
          for (int j = 0; j < 4; ++j) { gt[j] = fminf(gt[j], 7.0f); up[j] = __builtin_amdgcn_fmed3f(up[j], -7.0f, 7.0f); }
          const f32x4 z = gt * (-1.702f * 1.4426950408889634f);
#pragma unroll
          for (int j = 0; j < 4; ++j) e[j] = __builtin_amdgcn_exp2f(z[j]);
          constexpr float OSI = OUT8 ? 1.0f / A8SCALE : 1.0f;
          const f32x4 d = e * OSI + OSI;
#pragma unroll
          for (int j = 0; j < 4; ++j) r[j] = __builtin_amdgcn_rcpf(d[j]);
          const f32x4 glu = gt * r; o[n] = up * glu + glu; }
        if constexpr (OUT8) { int p0 = 0, p1 = 0;
          p0 = __builtin_amdgcn_cvt_pk_fp8_f32(o[0][0], o[0][1], p0, false); p0 = __builtin_amdgcn_cvt_pk_fp8_f32(o[0][2], o[0][3], p0, true);
          p1 = __builtin_amdgcn_cvt_pk_fp8_f32(o[1][0], o[1][1], p1, false); p1 = __builtin_amdgcn_cvt_pk_fp8_f32(o[1][2], o[1][3], p1, true);
          u32x2 w; w.x = (unsigned)p0; w.y = (unsigned)p1; *(u32x2*)((unsigned char*)O + (size_t)(row0 + ai * HALF + m * 16) * ACLD + j0) = w; }
        else { u32x4 w; w.x = cvt_pk_bf16(o[0][0], o[0][1]); w.y = cvt_pk_bf16(o[0][2], o[0][3]); w.z = cvt_pk_bf16(o[1][0], o[1][1]); w.w = cvt_pk_bf16(o[1][2], o[1][3]);
          *(u32x4*)(O + (size_t)(row0 + ai * HALF + m * 16) * ACLD + j0) = w; } }
  }
};
template <bool IN8, bool OUT8> struct EpiDownT {
  static constexpr bool PERM = true;
  bf16_t* O; const float* b_down;
  DEV void operator()(const f32x4 (&acc)[2][2][4][2], const Unit& u, int wr, int wc, int fr, int fq) const {
    const int row0 = u.pm * BM + wr * 64 + fr, col0 = u.pn * BM + wc * 32 + 8 * fq; const float* bd = b_down + (size_t)u.e * 1024 + col0;
    f32x4 bv[2][2];
#pragma unroll
    for (int bj = 0; bj < 2; ++bj)
#pragma unroll
      for (int n = 0; n < 2; ++n) bv[bj][n] = *(const f32x4*)(bd + bj * HALF + 4 * n);
#pragma unroll
    for (int ai = 0; ai < 2; ++ai)
#pragma unroll
      for (int m = 0; m < 4; ++m) { bf16_t* rowp = O + (size_t)(row0 + ai * HALF + m * 16) * ACLD + col0;
#pragma unroll
        for (int bj = 0; bj < 2; ++bj) { constexpr float ISC = IN8 ? 1.0f / (W8SCALE * A8SCALE) : 1.0f; const f32x4 v0 = acc[ai][bj][m][0] * ISC + bv[bj][0], v1 = acc[ai][bj][m][1] * ISC + bv[bj][1]; if constexpr (OUT8) { f32x4 a0 = v0 * Y8SCALE, a1 = v1 * Y8SCALE;
#pragma unroll
            for (int j = 0; j < 4; ++j) { a0[j] = __builtin_amdgcn_fmed3f(a0[j], -448.0f, 448.0f); a1[j] = __builtin_amdgcn_fmed3f(a1[j], -448.0f, 448.0f); }
            int p0 = 0, p1 = 0; p0 = __builtin_amdgcn_cvt_pk_fp8_f32(a0[0], a0[1], p0, false); p0 = __builtin_amdgcn_cvt_pk_fp8_f32(a0[2], a0[3], p0, true); p1 = __builtin_amdgcn_cvt_pk_fp8_f32(a1[0], a1[1], p1, false); p1 = __builtin_amdgcn_cvt_pk_fp8_f32(a1[2], a1[3], p1, true);
            u32x2 w8; w8.x = (unsigned)p0; w8.y = (unsigned)p1; *(u32x2*)((unsigned char*)O + (size_t)(row0 + ai * HALF + m * 16) * ACLD + col0 + bj * HALF) = w8; }
          else { u32x4 w; w.x = cvt_pk_bf16(v0[0], v0[1]); w.y = cvt_pk_bf16(v0[2], v0[3]); w.z = cvt_pk_bf16(v1[0], v1[1]); w.w = cvt_pk_bf16(v1[2], v1[3]);
          *(u32x4*)(rowp + bj * HALF) = w; } } }
  }
};

typedef int i32x8 __attribute__((ext_vector_type(8)));
DEV f32x4 mfma_f8(const bf16x8& b0, const bf16x8& b1, const bf16x8& a0, const bf16x8& a1, f32x4 c) {
  const u32x4 x0 = __builtin_bit_cast(u32x4, b0), x1 = __builtin_bit_cast(u32x4, b1), y0 = __builtin_bit_cast(u32x4, a0), y1 = __builtin_bit_cast(u32x4, a1);
  const i32x8 A = {(int)x0.x, (int)x0.y, (int)x0.z, (int)x0.w, (int)x1.x, (int)x1.y, (int)x1.z, (int)x1.w}, B = {(int)y0.x, (int)y0.y, (int)y0.z, (int)y0.w, (int)y1.x, (int)y1.y, (int)y1.z, (int)y1.w};
  return __builtin_amdgcn_mfma_scale_f32_16x16x128_f8f6f4(A, B, c, 0, 0, 0, 0x7f7f7f7f, 0, 0x7f7f7f7f);
}
template <class Epi, class Sched, bool F8 = false>
DEV void gemm_phase(LAS unsigned char* lds, const void* Abase, const Sched& S, const Epi& E, int wv) {
  const int tid = otid(wv), wid = __builtin_amdgcn_readfirstlane(tid >> 6), lane = tid & 63, wr = wid >> 2, wc = wid & 3, fr = lane & 15, fq = lane >> 4;
  const int K = S.K, nt = K / BK;
  int Rr[2], Cc[2]; unsigned voffB[2];
#pragma unroll
  for (int i = 0; i < 2; ++i) { int R, C; stage_rc(tid * 16 + i * 8192, R, C); Rr[i] = R; Cc[i] = C; const int Rb = Epi::PERM ? ((R & ~31) + perm32(R & 31)) : R; voffB[i] = (unsigned)(Rb * K + C) * 2u; }
  const size_t kstep = (size_t)(BK * 2), hstep = (size_t)HALF * K * 2;
  const unsigned ldsw = (unsigned)wid * 1024u;
  const int aoff = lds_byte(wr * 64 + fr, fq * 8), boff = lds_byte(wc * 32 + fr, fq * 8);
  const char* Ab = (const char*)Abase;
#define G_SA(b, h) (((b) * 2 + (h)) * HTB)
#define G_SB(b, h) ((4 + (b) * 2 + (h)) * HTB)
#define G_STAGEB(bufoff, gbase) do { _Pragma("unroll") for (int _i = 0; _i < 2; ++_i) \
    __builtin_amdgcn_global_load_lds((const unsigned*)((const char*)(gbase) + voffB[_i]), (LAS unsigned*)(lds + (bufoff) + ldsw + _i * 8192), 16, 0, 0); } while (0)
#define G_STAGEA(bufoff, gbase, offs) do { _Pragma("unroll") for (int _i = 0; _i < 2; ++_i) \
    __builtin_amdgcn_global_load_lds((const unsigned*)((const char*)(gbase) + (offs)[_i]), (LAS unsigned*)(lds + (bufoff) + ldsw + _i * 8192), 16, 0, 0); } while (0)
#define G_LDA(dst, b, h) do { _Pragma("unroll") for (int m = 0; m < 4; ++m) _Pragma("unroll") for (int k = 0; k < 2; ++k) dst[m][k] = *(const LAS bf16x8*)(lds + G_SA(b, h) + aoff + m * 2048 + k * 1024); } while (0)
#define G_LDB(dst, b, h) do { _Pragma("unroll") for (int n = 0; n < 2; ++n) _Pragma("unroll") for (int k = 0; k < 2; ++k) dst[n][k] = *(const LAS bf16x8*)(lds + G_SB(b, h) + boff + n * 2048 + k * 1024); } while (0)
#define G_MMA(ai, bj, At, Bt) do { __builtin_amdgcn_s_setprio(1); _Pragma("unroll") for (int m = 0; m < 4; ++m) _Pragma("unroll") for (int n = 0; n < 2; ++n) { \
    if constexpr (F8) acc[ai][bj][m][n] = mfma_f8(Bt[n][0], Bt[n][1], At[m][0], At[m][1], acc[ai][bj][m][n]); \
    else { _Pragma("unroll") for (int k = 0; k < 2; ++k) acc[ai][bj][m][n] = __builtin_amdgcn_mfma_f32_16x16x32_bf16(Bt[n][k], At[m][k], acc[ai][bj][m][n], 0, 0, 0); } } __builtin_amdgcn_s_setprio(0); } while (0)
#define G_WAIT_V(n) asm volatile("s_waitcnt vmcnt(" #n ")" ::: "memory")
#define G_WAIT_L(n) asm volatile("s_waitcnt lgkmcnt(" #n ")" ::: "memory")
#define G_BAR __builtin_amdgcn_s_barrier()
#define G_SCHED __builtin_amdgcn_sched_barrier(0)
  Unit cur, nxt; int ui = 0;
  if (!S.next(0, cur)) return;
  f32x4 acc[2][2][4][2];
#pragma unroll
  for (int a = 0; a < 2; ++a)
#pragma unroll
    for (int b = 0; b < 2; ++b)
#pragma unroll
      for (int m = 0; m < 4; ++m)
#pragma unroll
        for (int n = 0; n < 2; ++n) acc[a][b][m][n] = (f32x4){0.f, 0.f, 0.f, 0.f};
  bf16x8 At[4][2], B0[2][2], B1[2][2];
  unsigned aN0[2] = {0u, 0u}, aN1[2] = {0u, 0u};
  unsigned aC0[2], aC1[2];
#pragma unroll
  for (int i = 0; i < 2; ++i) { aC0[i] = S.arow_off(cur, Rr[i]) + (unsigned)Cc[i] * 2u; aC1[i] = S.arow_off(cur, HALF + Rr[i]) + (unsigned)Cc[i] * 2u; }
  const char* cB = S.bptr(cur);
  G_STAGEB(G_SB(0, 0), cB); G_STAGEB(G_SB(0, 1), cB + hstep); G_STAGEA(G_SA(0, 0), Ab, aC0); G_STAGEA(G_SA(0, 1), Ab, aC1);
  if (wr == 1) G_BAR;
  G_WAIT_V(2); G_BAR;
  G_STAGEB(G_SB(1, 0), cB + kstep); G_STAGEA(G_SA(1, 0), Ab + kstep, aC0); G_STAGEB(G_SB(1, 1), cB + hstep + kstep);
  G_WAIT_V(6); G_BAR;
#define G_TRIP(t, WAITA, WAITB) do { \
      const bool last = ((t) == nt - 2); \
      const char* a1 = Ab + (size_t)((t) + 1) * kstep; \
      const char* a2 = last ? Ab : Ab + (size_t)((t) + 2) * kstep; const char* b2 = last ? nB : cB + (size_t)((t) + 2) * kstep; \
      const char* a3 = a2 + kstep; const char* b3 = b2 + kstep; \
      G_LDB(B0, 0, 0); G_LDB(B1, 0, 1); G_SCHED; G_LDA(At, 0, 0); G_STAGEA(G_SA(1, 1), a1, aC1); \
      if (last && has_next) { \
        if constexpr (Sched::PREFETCH_ROWS) { _Pragma("unroll") for (int i = 0; i < 2; ++i) { aC0[i] = aN0[i]; aC1[i] = aN1[i]; } } \
        else { _Pragma("unroll") for (int i = 0; i < 2; ++i) { aC0[i] = S.arow_off(nxt, Rr[i]) + (unsigned)Cc[i] * 2u; aC1[i] = S.arow_off(nxt, HALF + Rr[i]) + (unsigned)Cc[i] * 2u; } } \
      } \
      WAITA; G_WAIT_L(0); G_BAR; G_MMA(0, 0, At, B0); G_MMA(0, 1, At, B1); G_BAR; G_SCHED; \
      G_LDA(At, 0, 1); G_STAGEB(G_SB(0, 0), b2); G_STAGEB(G_SB(0, 1), b2 + hstep); G_STAGEA(G_SA(0, 0), a2, aC0); \
      WAITB; G_WAIT_L(0); G_BAR; G_MMA(1, 0, At, B0); G_MMA(1, 1, At, B1); G_BAR; G_SCHED; \
      G_LDB(B0, 1, 0); G_LDB(B1, 1, 1); G_SCHED; G_LDA(At, 1, 0); G_STAGEA(G_SA(0, 1), a2, aC1); \
      G_WAIT_V(8); G_WAIT_L(0); G_BAR; G_MMA(0, 0, At, B0); G_MMA(0, 1, At, B1); G_BAR; G_SCHED; \
      G_LDA(At, 1, 1); G_STAGEB(G_SB(1, 0), b3); G_STAGEB(G_SB(1, 1), b3 + hstep); G_STAGEA(G_SA(1, 0), a3, aC0); \
      G_WAIT_V(8); G_WAIT_L(0); G_BAR; G_MMA(1, 0, At, B0); G_MMA(1, 1, At, B1); G_BAR; G_SCHED; \
    } while (0)
  for (;;) {
    const bool has_next = S.next(ui + 1, nxt);
    const char* nB = has_next ? S.bptr(nxt) : cB;
    if constexpr (Sched::PREFETCH_ROWS) { if (has_next) {
#pragma unroll
      for (int i = 0; i < 2; ++i) { aN0[i] = S.arow_off(nxt, Rr[i]) + (unsigned)Cc[i] * 2u; aN1[i] = S.arow_off(nxt, HALF + Rr[i]) + (unsigned)Cc[i] * 2u; } } }
#pragma unroll 1
    for (int t = 0; t < nt; t += 2) G_TRIP(t, G_WAIT_V(8), G_WAIT_V(8));
    if (wr == 0) G_BAR;
    E(acc, cur, wr, wc, fr, fq);
    if (!has_next) break;
#pragma unroll
    for (int a = 0; a < 2; ++a)
#pragma unroll
      for (int b = 0; b < 2; ++b)
#pragma unroll
        for (int m = 0; m < 4; ++m)
#pragma unroll
          for (int n = 0; n < 2; ++n) acc[a][b][m][n] = (f32x4){0.f, 0.f, 0.f, 0.f};
    cur = nxt; cB = nB; ++ui;
    if (wr == 1) G_BAR;
  }
  G_WAIT_V(0);
  G_BAR;
#undef G_SA
#undef G_SB
#undef G_STAGEA
#undef G_STAGEB
#undef G_LDA
#undef G_LDB
#undef G_MMA
#undef G_WAIT_V
#undef G_TRIP
#undef G_WAIT_L
#undef G_BAR
#undef G_SCHED
}
constexpr float QPRE = 0.07216878364870323f * 1.4426950408889634f;
DEV void p5_qkv_final(const Params& p) {
  const bf16_t* __restrict__ qraw = (const bf16_t*)(p.ws + A_QRAW); const bf16_t* __restrict__ kvraw = (const bf16_t*)(p.ws + A_KVRAW); const bf16_t* __restrict__ hcat = (const bf16_t*)(p.ws + A_HCAT);
  bf16_t* __restrict__ qf = (bf16_t*)(p.ws + A_QF); bf16_t* __restrict__ kf = (bf16_t*)(p.ws + A_KF); bf16_t* __restrict__ vf = (bf16_t*)(p.ws + A_VF);
  constexpr int RB = 2;
  const int tid = otid(p.wv), wid = tid >> 6, lane = tid & 63;
  const int ax = lane >> 5, fi = lane & 15, second = (lane >> 4) & 1;
  const float invf = exp2f(-(float)fi * (13.287712379549449f / 16.0f));
  const float gq0 = p.qn_g[lane], gq1 = p.qn_g[64 + lane], gq2 = p.qn_g[128 + lane], gk0 = p.kn_g[lane], gk1 = p.kn_g[64 + lane], gk2 = p.kn_g[128 + lane];
  for (int r0 = (blockIdx.x * 8 + wid) * RB; r0 < NTOK; r0 += gridDim.x * 8 * RB) {
    unsigned short qe[RB][4][3], ke[RB][4][4], kp[RB]; u32x2 lq[RB]; unsigned lk[RB];
#pragma unroll
    for (int j = 0; j < RB; ++j) { const int r = r0 + j; const bf16_t* hrow = hcat + (size_t)r * HCLD;
      kp[j] = hrow[PECOL + lane]; lq[j] = *(const u32x2*)(hrow + CQCOL + lane * 4); lk[j] = *(const unsigned*)(hrow + KVCOL + lane * 2);
#pragma unroll
      for (int h = 0; h < NHEAD; ++h) { const bf16_t* s = qraw + (size_t)r * 768 + h * QKD; qe[j][h][0] = s[lane]; qe[j][h][1] = s[64 + lane]; qe[j][h][2] = s[128 + lane];
        const bf16_t* s2 = kvraw + (size_t)r * ACLD + h * 256; ke[j][h][0] = s2[lane]; ke[j][h][1] = s2[64 + lane]; ke[j][h][2] = s2[128 + lane]; ke[j][h][3] = s2[192 + lane]; } }
#pragma unroll
    for (int j = 0; j < RB; ++j) { const int r = r0 + j;
      const int b = r >> 13, t = r & 8191; const float pos = (float)(ax ? (t & 63) : (t >> 6)); float sn, cs; sincosf(pos * invf, &sn, &cs);
      const float kpe = bf2f(kp[j]);
      float rq, rk;
      { const float a = bflo(lq[j].x), bb = bfhi(lq[j].x), c = bflo(lq[j].y), d = bfhi(lq[j].y); rq = rsqrtf(wave_sum(a * a + bb * bb + c * c + d * d) * (1.0f / 256.0f) + NORM_EPS);
        const float e = bflo(lk[j]), f = bfhi(lk[j]); rk = rsqrtf(wave_sum(e * e + f * f) * (1.0f / 128.0f) + NORM_EPS); }
      const size_t kvrow = (size_t)(b * SKV + t);
#pragma unroll
      for (int h = 0; h < NHEAD; ++h) {
        { const float e0 = rq * bf2f(qe[j][h][0]), e1 = rq * bf2f(qe[j][h][1]), e2 = rq * bf2f(qe[j][h][2]);
          const float rs = rsqrtf(wave_sum(e0 * e0 + e1 * e1 + e2 * e2) * (1.0f / 192.0f) + NORM_EPS); const float n0 = e0 * rs * gq0, n1 = e1 * rs * gq1, n2 = e2 * rs * gq2;
          const float pt = swz_xor<16>(n2); const float r2 = n2 * cs + (second ? pt : -pt) * sn;
          bf16_t* d = qf + (size_t)r * 768 + h * QKD; d[lane] = (bf16_t)f2bf(n0 * QPRE); d[64 + lane] = (bf16_t)f2bf(n1 * QPRE); d[128 + lane] = (bf16_t)f2bf(r2 * QPRE); }
        { const float e0 = rk * bf2f(ke[j][h][0]), e1 = rk * bf2f(ke[j][h][1]), e2 = kpe;
          const float rs = rsqrtf(wave_sum(e0 * e0 + e1 * e1 + e2 * e2) * (1.0f / 192.0f) + NORM_EPS); const float n0 = e0 * rs * gk0, n1 = e1 * rs * gk1, n2 = e2 * rs * gk2;
          const float pt = swz_xor<16>(n2); const float r2 = n2 * cs + (second ? pt : -pt) * sn;
          bf16_t* d = kf + kvrow * 768 + h * QKD; d[lane] = (bf16_t)f2bf(n0); d[64 + lane] = (bf16_t)f2bf(n1); d[128 + lane] = (bf16_t)f2bf(r2);
          bf16_t* dv = vf + kvrow * 512 + h * VDIM; dv[lane] = (bf16_t)f2bf(rk * bf2f(ke[j][h][2])); dv[64 + lane] = (bf16_t)f2bf(rk * bf2f(ke[j][h][3])); }
      }
    }
  }
}

namespace att {
constexpr int NW = 8, QBLK = 32, KVBLK = 64;
constexpr int LDQ = 768, LDKK = 768, LDKV = 512, LDO = 1024;
constexpr int SHM_V = KVBLK * VDIM * 2, SHM_K = KVBLK * QKD * 2;
constexpr int SHM_ATTN = 3 * (SHM_V + SHM_K) + NW * 64 * 4;
#define SBAR() __builtin_amdgcn_sched_barrier(0)
DEV unsigned cvtpk(float lo, float hi) { unsigned r; asm volatile("v_cvt_pk_bf16_f32 %0, %1, %2" : "=v"(r) : "v"(lo), "v"(hi)); return r; }
#define EX(P, R, LS) do { P[R] = __builtin_amdgcn_exp2f(P[R]); } while (0)
#define PA(OUT, PLO, PHI) do { u32x4 w_ = {cvtpk(PLO[0], PLO[1]), cvtpk(PLO[2], PLO[3]), cvtpk(PHI[0], PHI[1]), cvtpk(PHI[2], PHI[3])}; OUT = *reinterpret_cast<bf16x8*>(&w_); } while (0)
#define MF16(A, B, C) __builtin_amdgcn_mfma_f32_16x16x32_bf16(A, B, C, 0, 0, 0)
template <int OFF> DEV s16x4 tr_read(int vb) { s16x4 r; asm volatile("ds_read_b64_tr_b16 %0, %1 offset:%2" : "=&v"(r) : "v"(vb), "i"(OFF) : "memory"); return r; }
template <int OFF> DEV bf16x8 k_read(int a) { bf16x8 r; asm volatile("ds_read_b128 %0, %1 offset:%2" : "=&v"(r) : "v"(a), "i"(OFF) : "memory"); return r; }
#define PKV(L, H) (bf16x8){L[0], L[1], L[2], L[3], H[0], H[1], H[2], H[3]}
#define LGK(N) asm volatile("s_waitcnt lgkmcnt(" #N ")" ::: "memory")
template <class DMA> DEV void att_tile(f32x4 (&o)[16], f32x4 (&lacc)[2], int ka0, int ka1, int vb, const bf16x8 (&qr)[12], const f32x4& cinit, const bf16x8& ones, const DMA& dma) {
  bf16x8 kf[6]; kf[0] = k_read<0>(ka0); kf[1] = k_read<0>(ka1); kf[2] = k_read<128>(ka0); kf[3] = k_read<128>(ka1); kf[4] = k_read<256>(ka0);
  f32x4 p[8]; bf16x8 pa[4]; s16x4 vv[6][2]; int l0 = 0, l1 = 0; (void)l0; (void)l1;
  kf[5] = k_read<256>(ka1); LGK(5); SBAR(); p[0] = MF16(kf[0], qr[0], cinit); p[1] = MF16(kf[0], qr[6], cinit); SBAR();
  kf[0] = k_read<6144>(ka0); LGK(5); SBAR(); p[0] = MF16(kf[1], qr[1], p[0]); p[1] = MF16(kf[1], qr[7], p[1]); dma(0); SBAR();
  kf[1] = k_read<6144>(ka1); LGK(5); SBAR(); p[0] = MF16(kf[2], qr[2], p[0]); p[1] = MF16(kf[2], qr[8], p[1]); SBAR();
  kf[2] = k_read<6272>(ka0); LGK(5); SBAR(); p[0] = MF16(kf[3], qr[3], p[0]); p[1] = MF16(kf[3], qr[9], p[1]); dma(1); SBAR();
  kf[3] = k_read<6272>(ka1); LGK(5); SBAR(); p[0] = MF16(kf[4], qr[4], p[0]); p[1] = MF16(kf[4], qr[10], p[1]); SBAR();
  kf[4] = k_read<6400>(ka0); LGK(5); SBAR(); p[0] = MF16(kf[5], qr[5], p[0]); p[1] = MF16(kf[5], qr[11], p[1]); dma(2); SBAR();
  kf[5] = k_read<6400>(ka1); LGK(5); SBAR(); p[2] = MF16(kf[0], qr[0], cinit); p[3] = MF16(kf[0], qr[6], cinit); SBAR();
  kf[0] = k_read<12288>(ka0); LGK(5); SBAR(); p[2] = MF16(kf[1], qr[1], p[2]); p[3] = MF16(kf[1], qr[7], p[3]); dma(3); SBAR();
  kf[1] = k_read<12288>(ka1); LGK(5); SBAR(); p[2] = MF16(kf[2], qr[2], p[2]); p[3] = MF16(kf[2], qr[8], p[3]); SBAR();
  kf[2] = k_read<12416>(ka0); LGK(5); SBAR(); p[2] = MF16(kf[3], qr[3], p[2]); p[3] = MF16(kf[3], qr[9], p[3]); dma(4); SBAR();
  kf[3] = k_read<12416>(ka1); LGK(5); SBAR(); p[2] = MF16(kf[4], qr[4], p[2]); p[3] = MF16(kf[4], qr[10], p[3]); SBAR();
  kf[4] = k_read<12544>(ka0); LGK(5); SBAR(); p[2] = MF16(kf[5], qr[5], p[2]); p[3] = MF16(kf[5], qr[11], p[3]); SBAR();
  kf[5] = k_read<12544>(ka1); LGK(5); SBAR(); p[4] = MF16(kf[0], qr[0], cinit); p[5] = MF16(kf[0], qr[6], cinit); SBAR();
  kf[0] = k_read<18432>(ka0); LGK(5); SBAR(); p[4] = MF16(kf[1], qr[1], p[4]); p[5] = MF16(kf[1], qr[7], p[5]); EX(p[0], 0, l0); EX(p[0], 1, l0); SBAR();
  kf[1] = k_read<18432>(ka1); LGK(5); SBAR(); p[4] = MF16(kf[2], qr[2], p[4]); p[5] = MF16(kf[2], qr[8], p[5]); EX(p[0], 2, l0); EX(p[0], 3, l0); SBAR();
  kf[2] = k_read<18560>(ka0); LGK(5); SBAR(); p[4] = MF16(kf[3], qr[3], p[4]); p[5] = MF16(kf[3], qr[9], p[5]); EX(p[1], 0, l1); EX(p[1], 1, l1); SBAR();
  kf[3] = k_read<18560>(ka1); LGK(5); SBAR(); p[4] = MF16(kf[4], qr[4], p[4]); p[5] = MF16(kf[4], qr[10], p[5]); EX(p[1], 2, l1); EX(p[1], 3, l1); SBAR();
  kf[4] = k_read<18688>(ka0); LGK(5); SBAR(); p[4] = MF16(kf[5], qr[5], p[4]); p[5] = MF16(kf[5], qr[11], p[5]); EX(p[2], 0, l0); EX(p[2], 1, l0); SBAR();
  kf[5] = k_read<18688>(ka1); LGK(5); SBAR(); p[6] = MF16(kf[0], qr[0], cinit); p[7] = MF16(kf[0], qr[6], cinit); EX(p[2], 2, l0); EX(p[2], 3, l0); SBAR();
  vv[0][0] = tr_read<0>(vb); vv[0][1] = tr_read<512>(vb); LGK(6); SBAR(); p[6] = MF16(kf[1], qr[1], p[6]); p[7] = MF16(kf[1], qr[7], p[7]); EX(p[3], 0, l1); EX(p[3], 1, l1); EX(p[4], 0, l0); SBAR();
  vv[1][0] = tr_read<2048>(vb); vv[1][1] = tr_read<2560>(vb); LGK(7); SBAR(); p[6] = MF16(kf[2], qr[2], p[6]); p[7] = MF16(kf[2], qr[8], p[7]); EX(p[3], 2, l1); EX(p[3], 3, l1); EX(p[4], 1, l0); SBAR();
  vv[2][0] = tr_read<4096>(vb); vv[2][1] = tr_read<4608>(vb); LGK(8); SBAR(); p[6] = MF16(kf[3], qr[3], p[6]); p[7] = MF16(kf[3], qr[9], p[7]); PA(pa[0], p[0], p[2]); EX(p[4], 2, l0); SBAR();
  vv[3][0] = tr_read<6144>(vb); vv[3][1] = tr_read<6656>(vb); LGK(9); SBAR(); p[6] = MF16(kf[4], qr[4], p[6]); p[7] = MF16(kf[4], qr[10], p[7]); PA(pa[1], p[1], p[3]); EX(p[4], 3, l0); EX(p[5], 0, l1); SBAR();
  vv[4][0] = tr_read<8192>(vb); vv[4][1] = tr_read<8704>(vb); LGK(10); SBAR(); p[6] = MF16(kf[5], qr[5], p[6]); p[7] = MF16(kf[5], qr[11], p[7]); EX(p[5], 1, l1); EX(p[5], 2, l1); EX(p[5], 3, l1); SBAR();
  vv[5][0] = tr_read<10240>(vb); vv[5][1] = tr_read<10752>(vb); LGK(10); SBAR(); o[0] = MF16(pa[0], PKV(vv[0][0], vv[0][1]), o[0]); o[8] = MF16(pa[1], PKV(vv[0][0], vv[0][1]), o[8]); lacc[0] = MF16(pa[0], ones, lacc[0]); lacc[1] = MF16(pa[1], ones, lacc[1]); EX(p[6], 0, l0); EX(p[6], 1, l0); SBAR();
  vv[0][0] = tr_read<12288>(vb); vv[0][1] = tr_read<12800>(vb); LGK(10); SBAR(); o[1] = MF16(pa[0], PKV(vv[1][0], vv[1][1]), o[1]); o[9] = MF16(pa[1], PKV(vv[1][0], vv[1][1]), o[9]); EX(p[6], 2, l0); EX(p[6], 3, l0); SBAR();
  vv[1][0] = tr_read<14336>(vb); vv[1][1] = tr_read<14848>(vb); LGK(10); SBAR(); o[2] = MF16(pa[0], PKV(vv[2][0], vv[2][1]), o[2]); o[10] = MF16(pa[1], PKV(vv[2][0], vv[2][1]), o[10]); EX(p[7], 0, l1); EX(p[7], 1, l1); SBAR();
  vv[2][0] = tr_read<1024>(vb); vv[2][1] = tr_read<1536>(vb); LGK(10); SBAR(); o[3] = MF16(pa[0], PKV(vv[3][0], vv[3][1]), o[3]); o[11] = MF16(pa[1], PKV(vv[3][0], vv[3][1]), o[11]); EX(p[7], 2, l1); EX(p[7], 3, l1); SBAR();
  vv[3][0] = tr_read<3072>(vb); vv[3][1] = tr_read<3584>(vb); LGK(10); SBAR(); o[4] = MF16(pa[0], PKV(vv[4][0], vv[4][1]), o[4]); o[12] = MF16(pa[1], PKV(vv[4][0], vv[4][1]), o[12]); PA(pa[2], p[4], p[6]); SBAR();
  vv[4][0] = tr_read<5120>(vb); vv[4][1] = tr_read<5632>(vb); LGK(10); SBAR(); o[5] = MF16(pa[0], PKV(vv[5][0], vv[5][1]), o[5]); o[13] = MF16(pa[1], PKV(vv[5][0], vv[5][1]), o[13]); PA(pa[3], p[5], p[7]); SBAR();
  vv[5][0] = tr_read<7168>(vb); vv[5][1] = tr_read<7680>(vb); LGK(10); SBAR(); o[6] = MF16(pa[0], PKV(vv[0][0], vv[0][1]), o[6]); o[14] = MF16(pa[1], PKV(vv[0][0], vv[0][1]), o[14]); SBAR();
  vv[0][0] = tr_read<9216>(vb); vv[0][1] = tr_read<9728>(vb); LGK(10); SBAR(); o[7] = MF16(pa[0], PKV(vv[1][0], vv[1][1]), o[7]); o[15] = MF16(pa[1], PKV(vv[1][0], vv[1][1]), o[15]); SBAR();
  vv[1][0] = tr_read<11264>(vb); vv[1][1] = tr_read<11776>(vb); LGK(10); SBAR(); o[0] = MF16(pa[2], PKV(vv[2][0], vv[2][1]), o[0]); o[8] = MF16(pa[3], PKV(vv[2][0], vv[2][1]), o[8]); lacc[0] = MF16(pa[2], ones, lacc[0]); lacc[1] = MF16(pa[3], ones, lacc[1]); SBAR();
  vv[2][0] = tr_read<13312>(vb); vv[2][1] = tr_read<13824>(vb); LGK(10); SBAR(); o[1] = MF16(pa[2], PKV(vv[3][0], vv[3][1]), o[1]); o[9] = MF16(pa[3], PKV(vv[3][0], vv[3][1]), o[9]); SBAR();
  vv[3][0] = tr_read<15360>(vb); vv[3][1] = tr_read<15872>(vb); LGK(10); SBAR(); o[2] = MF16(pa[2], PKV(vv[4][0], vv[4][1]), o[2]); o[10] = MF16(pa[3], PKV(vv[4][0], vv[4][1]), o[10]); SBAR();
  LGK(8); SBAR(); o[3] = MF16(pa[2], PKV(vv[5][0], vv[5][1]), o[3]); o[11] = MF16(pa[3], PKV(vv[5][0], vv[5][1]), o[11]); SBAR();
  LGK(6); SBAR(); o[4] = MF16(pa[2], PKV(vv[0][0], vv[0][1]), o[4]); o[12] = MF16(pa[3], PKV(vv[0][0], vv[0][1]), o[12]); SBAR();
  LGK(4); SBAR(); o[5] = MF16(pa[2], PKV(vv[1][0], vv[1][1]), o[5]); o[13] = MF16(pa[3], PKV(vv[1][0], vv[1][1]), o[13]); SBAR();
  LGK(2); SBAR(); o[6] = MF16(pa[2], PKV(vv[2][0], vv[2][1]), o[6]); o[14] = MF16(pa[3], PKV(vv[2][0], vv[2][1]), o[14]); SBAR();
  LGK(0); SBAR(); o[7] = MF16(pa[2], PKV(vv[3][0], vv[3][1]), o[7]); o[15] = MF16(pa[3], PKV(vv[3][0], vv[3][1]), o[15]); SBAR();
}
#undef LGK
#undef PKV
constexpr int RING = 3, LI_OFF = RING * (SHM_V + SHM_K);
DEV void attn_unit(const bf16_t* __restrict__ Qb, const bf16_t* __restrict__ Kh, const bf16_t* __restrict__ Vh, bf16_t* __restrict__ Ob, int seq, LAS unsigned char* ldsl, int wv, float negUC) {
  char* lds = (char*)ldsl;
  const int tid = otid(wv), wid = tid >> 6, lane = tid & 63, x = lane & 15, g = lane >> 4;
  char* V_lds = lds; char* K_lds = lds + RING * SHM_V;
  f32x4 lacc[2] = {{0.f, 0.f, 0.f, 0.f}, {0.f, 0.f, 0.f, 0.f}}; f32x4 o[16]; bf16x8 qr[12];
#pragma unroll
  for (int i = 0; i < 16; ++i) o[i] = (f32x4){0.f, 0.f, 0.f, 0.f};
#pragma unroll
  for (int qb = 0; qb < 2; ++qb)
#pragma unroll
    for (int ks = 0; ks < 6; ++ks) qr[qb * 6 + ks] = *reinterpret_cast<const bf16x8*>(Qb + (long)(wid * QBLK + 16 * qb + x) * LDQ + 32 * ks + 8 * g);
  unsigned kgo[3], vgo[2];
#pragma unroll
  for (int i = 0; i < 3; ++i) { const int q = tid + 512 * i, row = q / 24, cc = q - row * 24; kgo[i] = (unsigned)(row * LDKK * 2 + ((cc * 16) ^ (((row >> 1) & 7) << 4))); }
#pragma unroll
  for (int i = 0; i < 2; ++i) { const int q = tid + 512 * i, hf = q & 1, kin = (q >> 1) & 7, kg = (q >> 4) & 7, db = q >> 7; vgo[i] = (unsigned)(((kg * 8 + kin) * LDKV + 16 * db + 8 * hf) * 2); }
  const int vb0 = (int)(uintptr_t)V_lds + (g >> 1) * 256 + (4 * (g & 1) + (x >> 2)) * 32 + 8 * (x & 3);
  const int kt0 = 16 * (g ^ (x >> 1)), kq0 = (int)(uintptr_t)K_lds + x * 384 + kt0, kq1 = (int)(uintptr_t)K_lds + x * 384 + (kt0 ^ 64);
  const bf16x8 ones = {0x3F80, 0x3F80, 0x3F80, 0x3F80, 0x3F80, 0x3F80, 0x3F80, 0x3F80};
  f32x4 cinit = {negUC, negUC, negUC, negUC};
  const unsigned ldsw = (unsigned)wv * 1024u;
#define APIECE(SLOT, k0, I) do { if ((I) < 3) __builtin_amdgcn_global_load_lds((const unsigned*)((const char*)Kh + (size_t)(k0) * (LDKK * 2) + kgo[(I) < 3 ? (I) : 0]), (LAS unsigned*)(ldsl + RING * SHM_V + (SLOT) * SHM_K + ldsw + ((I) < 3 ? (I) : 0) * 8192), 16, 0, 0); \
    else __builtin_amdgcn_global_load_lds((const unsigned*)((const char*)Vh + (size_t)(k0) * (LDKV * 2) + vgo[(I) >= 3 ? (I) - 3 : 0]), (LAS unsigned*)(ldsl + (SLOT) * SHM_V + ldsw + ((I) >= 3 ? (I) - 3 : 0) * 8192), 16, 0, 0); } while (0)
#define ADMA(SLOT, k0) do { APIECE(SLOT, k0, 0); APIECE(SLOT, k0, 1); APIECE(SLOT, k0, 2); APIECE(SLOT, k0, 3); APIECE(SLOT, k0, 4); } while (0)
#define ATILE(SLOT, DSLOT, k0) att_tile(o, lacc, kq0 + (SLOT) * SHM_K, kq1 + (SLOT) * SHM_K, vb0 + (SLOT) * SHM_V, qr, cinit, ones, [&](int i) { switch (i) { case 0: APIECE(DSLOT, k0, 0); break; case 1: APIECE(DSLOT, k0, 1); break; case 2: APIECE(DSLOT, k0, 2); break; case 3: APIECE(DSLOT, k0, 3); break; default: APIECE(DSLOT, k0, 4); break; } })
#define ATILE0(SLOT) att_tile(o, lacc, kq0 + (SLOT) * SHM_K, kq1 + (SLOT) * SHM_K, vb0 + (SLOT) * SHM_V, qr, cinit, ones, [](int) {})
#define VM5() asm volatile("s_waitcnt vmcnt(5)" ::: "memory")
#define VM0() asm volatile("s_waitcnt vmcnt(0)" ::: "memory")
  const int NT = seq / KVBLK;
#define ABAR() do { SBAR(); __builtin_amdgcn_s_barrier(); SBAR(); } while (0)
  ADMA(0, 0); ADMA(1, KVBLK); VM5(); ABAR();
#pragma unroll 1
  for (int j = 0; j < NT - 3; j += 3) {
    ATILE(0, 2, (j + 2) * KVBLK); VM5(); ABAR();
    ATILE(1, 0, (j + 3) * KVBLK); VM5(); ABAR();
    ATILE(2, 1, (j + 4) * KVBLK); VM5(); ABAR();
  }
  ATILE(0, 2, (NT - 1) * KVBLK); VM5(); ABAR();
  ATILE0(1); VM0(); ABAR();
  ATILE0(2);
#undef ABAR
  {
    const int t2 = otid(wv), wid2 = t2 >> 6, x2 = t2 & 15, g2 = (t2 >> 4) & 3;
    bf16_t* Ow = Ob + (long)(wid2 * QBLK) * LDO;
#pragma unroll
    for (int qb = 0; qb < 2; ++qb)
#pragma unroll
      for (int r = 0; r < 4; ++r) { const float rl = __builtin_amdgcn_rcpf(lacc[qb][r]);
#pragma unroll
        for (int db = 0; db < 8; ++db) Ow[(long)(16 * qb + 4 * g2 + r) * LDO + 16 * db + x2] = (bf16_t)f2bf(o[qb * 8 + db][r] * rl); } }
  __syncthreads();
#undef ADMA
#undef APIECE
#undef ATILE
#undef ATILE0
#undef VM5
#undef VM0
}
}
DEV void p6_attention(const Params& p, LAS unsigned char* lds) {
  const bf16_t* qf = (const bf16_t*)(p.ws + A_QF); const bf16_t* kf = (const bf16_t*)(p.ws + A_KF); const bf16_t* vf = (const bf16_t*)(p.ws + A_VF); bf16_t* ymix = (bf16_t*)(p.ws + A_YMIX);
  const int G = gridDim.x, c = blockIdx.x;
  float negUC;
  { const int lane = otid(p.wv) & 63; float gq = 0.f, gk = 0.f;
#pragma unroll
    for (int i = 0; i < 3; ++i) { gq = fmaxf(gq, fabsf(p.qn_g[lane + 64 * i])); gk = fmaxf(gk, fabsf(p.kn_g[lane + 64 * i])); }
    gq = wave_max(gq); gk = wave_max(gk);
    negUC = -(13.856406460551018f * gq * gk) * 1.4426950408889634f * 1.0005f; }
  for (int i = 0;; ++i) {
    long u = (long)i * G + c; if (u >= 512) break;
    if (G == 256) { const int vcu = (c & 7) * 32 + (c >> 3); u = (long)i * 256 + vcu; }
    const int bh = (int)(u >> 5), qb = (int)(u & 31), b = bh >> 2, h = bh & 3;
    att::attn_unit(qf + ((size_t)(b * SEQ + qb * 256)) * 768 + h * QKD, kf + (size_t)b * SKV * 768 + h * QKD, vf + (size_t)b * SKV * 512 + h * VDIM,
                   ymix + ((size_t)(b * SEQ + qb * 256)) * 1024 + 512 + h * VDIM,
                   SKV,
                   lds, p.wv, negUC);
  }
}
DEV void p9_router(const Params& p, LAS unsigned char* lds, const float* mod);
DEV void p9_route(const Params& p, LAS unsigned char* lds, int ch0, int ch1, int chstep) {
  LAS int* lcnt = (LAS int*)lds; LAS int* lbase = lcnt + 32;
  const float* logit = (const float*)(p.ws + OFF_LOGIT); int* paire = (int*)(p.ws + OFF_PAIRE); int* pairr = (int*)(p.ws + OFF_PAIRR); float* pairg = (float*)(p.ws + OFF_PAIRG);
  int* rowtok = (int*)(p.ws + OFF_ROWTOK); int* cnt = (int*)(p.ws + OFF_CTL);
  const int tid = otid(p.wv);
  for (int ch = ch0; ch < ch1; ch += chstep) {
    if (tid < 32) lcnt[tid] = 0;
    __syncthreads();
    int se[4] = {0, 0, 0, 0}, lr[4] = {0, 0, 0, 0}; const int tok = ch * 128 + tid;
    if (tid < 128) {
      float lg[32];
#pragma unroll
      for (int q = 0; q < 8; ++q) { const f32x4 v = *(const f32x4*)(logit + (size_t)tok * 32 + q * 4), bb = *(const f32x4*)(p.router_b + q * 4); lg[q * 4] = v[0] + bb[0]; lg[q * 4 + 1] = v[1] + bb[1]; lg[q * 4 + 2] = v[2] + bb[2]; lg[q * 4 + 3] = v[3] + bb[3]; }
      float sv[4]; unsigned mask = 0u;
#pragma unroll
      for (int k = 0; k < 4; ++k) { float best = -3.0e38f; int bi = 0;
#pragma unroll
        for (int j = 0; j < 32; ++j) { const bool free_ = ((mask >> j) & 1u) == 0u; if (free_ && lg[j] > best) { best = lg[j]; bi = j; } }
        mask |= 1u << bi; se[k] = bi; sv[k] = best; }
      const float e1 = __expf(sv[1] - sv[0]), e2 = __expf(sv[2] - sv[0]), e3 = __expf(sv[3] - sv[0]); const float inv = 1.0f / (1.0f + e1 + e2 + e3);
      const f32x4 gt = {inv, e1 * inv, e2 * inv, e3 * inv}; *(f32x4*)(pairg + (size_t)tok * 4) = gt;
#pragma unroll
      for (int k = 0; k < 4; ++k) { paire[tok * 4 + k] = se[k]; lr[k] = __hip_atomic_fetch_add(&lcnt[se[k]], 1, __ATOMIC_RELAXED, __HIP_MEMORY_SCOPE_WORKGROUP); }
    }
    __syncthreads();
    if (tid < 32) lbase[tid] = atomicAdd(&cnt[tid], lcnt[tid]);
    __syncthreads();
    if (tid < 128) {
#pragma unroll
      for (int k = 0; k < 4; ++k) { const int rk = lbase[se[k]] + lr[k]; pairr[tok * 4 + k] = rk; rowtok[(size_t)se[k] * NTOK + rk] = tok; }
    }
    __syncthreads();
  }
}
DEV void norm2_load(f32x4 (&v)[4][4], const float* __restrict__ src, int wv, int rowbase) {
  const int tid = otid(wv), wid = tid >> 6, lane = tid & 63; const int r0 = rowbase + wid * 4;
#pragma unroll
  for (int j = 0; j < 4; ++j)
#pragma unroll
    for (int q = 0; q < 4; ++q) v[j][q] = *(const f32x4*)(src + (size_t)(r0 + j) * 1024 + q * 256 + lane * 4);
}
DEV void norm2_rows_lds(const f32x4 (&v)[4][4], const float* __restrict__ g, const float* __restrict__ mod0, LAS unsigned char* hl, int hstr, int wv, int rowbase, int lrow0, unsigned char* __restrict__ dst8) {
  constexpr int RB = 4;
  const int tid = otid(wv), wid = tid >> 6, lane = tid & 63;
  const int r0 = rowbase + wid * RB;
  const float* mrow = mod0 + (size_t)(r0 >> 13) * 6144;
  f32x4 gg[4], sc[4], sh[4];
#pragma unroll
  for (int q = 0; q < 4; ++q) { const int col = q * 256 + lane * 4; gg[q] = *(const f32x4*)(g + col); sc[q] = *(const f32x4*)(mrow + 4096 + col); sh[q] = *(const f32x4*)(mrow + 3072 + col); }
#pragma unroll
  for (int j = 0; j < RB; ++j) {
    float ss = 0.f;
#pragma unroll
    for (int q = 0; q < 4; ++q) ss += v[j][q][0] * v[j][q][0] + v[j][q][1] * v[j][q][1] + v[j][q][2] * v[j][q][2] + v[j][q][3] * v[j][q][3];
    ss = wave_sum(ss); const float rs = rsqrtf(ss * (1.0f / 1024.0f) + NORM_EPS);
#pragma unroll
    for (int q = 0; q < 4; ++q) { float o[4];
#pragma unroll
      for (int e = 0; e < 4; ++e) o[e] = v[j][q][e] * rs * gg[q][e] * (1.0f + sc[q][e]) + sh[q][e];
      u32x2 w; w.x = pk2(o[0], o[1]); w.y = pk2(o[2], o[3]); *(LAS u32x2*)(hl + (lrow0 + wid * RB + j) * hstr + (q * 256 + lane * 4) * 2) = w;
      float c8[4];
#pragma unroll
      for (int e = 0; e < 4; ++e) c8[e] = __builtin_amdgcn_fmed3f(o[e], -448.0f, 448.0f);
      int pk = 0; pk = __builtin_amdgcn_cvt_pk_fp8_f32(c8[0], c8[1], pk, false); pk = __builtin_amdgcn_cvt_pk_fp8_f32(c8[2], c8[3], pk, true); *(int*)(dst8 + (size_t)(r0 + j) * 1024 + q * 256 + lane * 4) = pk; }
  }
}
DEV void p9_router(const Params& p, LAS unsigned char* lds, const float* mod) {
  static_assert(F8_G1 != 0, "the LDS-staged router assumes the expert GEMM reads the e4m3 copy");
  constexpr int HSTR = 2064; LAS unsigned char* hl = lds + 1024; LAS float* part = (LAS float*)(lds + 1024 + 64 * HSTR);
  const bf16_t* __restrict__ wrt = (const bf16_t*)(p.ws + OFF_WRT); float* __restrict__ logit = (float*)(p.ws + OFF_LOGIT);
  const int tid = otid(p.wv), wid = tid >> 6, lane = tid & 63, x = lane & 15, g = lane >> 4;
  const int rg = wid & 3, kh = wid >> 2;
  unsigned char* h8 = (unsigned char*)(p.ws + A_H2F8);
  for (int ch = blockIdx.x; ch < 256; ch += gridDim.x) {
    f32x4 va[4][4], vb[4][4];
    norm2_load(va, p.out, p.wv, ch * 128);
#pragma unroll
    for (int hf = 0; hf < 2; ++hf) {
      norm2_load(vb, p.out, p.wv, ch * 128 + hf * 64 + 32);
      norm2_rows_lds(va, p.norm2_g, mod, hl, HSTR, p.wv, ch * 128 + hf * 64, 0, h8);
      if (hf == 0) norm2_load(va, p.out, p.wv, ch * 128 + 64);
      norm2_rows_lds(vb, p.norm2_g, mod, hl, HSTR, p.wv, ch * 128 + hf * 64 + 32, 32, h8);
      asm volatile("s_waitcnt lgkmcnt(0)" ::: "memory"); __builtin_amdgcn_s_barrier();
      const LAS unsigned char* ar = hl + (rg * 16 + x) * HSTR + (kh * 512 + 8 * g) * 2;
      const bf16_t* b0 = wrt + (size_t)x * 1024 + kh * 512 + 8 * g; const bf16_t* b1 = wrt + (size_t)(16 + x) * 1024 + kh * 512 + 8 * g;
      f32x4 acc0 = {0.f, 0.f, 0.f, 0.f}, acc1 = {0.f, 0.f, 0.f, 0.f};
#pragma unroll 8
      for (int ks = 0; ks < 16; ++ks) { const bf16x8 a = *(const LAS bf16x8*)(ar + 64 * ks), w0 = *(const bf16x8*)(b0 + 32 * ks), w1 = *(const bf16x8*)(b1 + 32 * ks);
        acc0 = __builtin_amdgcn_mfma_f32_16x16x32_bf16(a, w0, acc0, 0, 0, 0); acc1 = __builtin_amdgcn_mfma_f32_16x16x32_bf16(a, w1, acc1, 0, 0, 0); }
      if (kh == 1) {
#pragma unroll
        for (int r = 0; r < 4; ++r) { LAS float* pr = part + (rg * 16 + 4 * g + r) * 32; pr[x] = acc0[r]; pr[16 + x] = acc1[r]; } }
      asm volatile("s_waitcnt lgkmcnt(0)" ::: "memory"); __builtin_amdgcn_s_barrier();
      if (kh == 0) { const int row0 = ch * 128 + hf * 64 + rg * 16;
#pragma unroll
        for (int r = 0; r < 4; ++r) { float* lr = logit + (size_t)(row0 + 4 * g + r) * 32; const LAS float* pr = part + (rg * 16 + 4 * g + r) * 32; lr[x] = acc0[r] + pr[x]; lr[16 + x] = acc1[r] + pr[16 + x]; } }
    }
    asm volatile("s_waitcnt vmcnt(0)" ::: "memory"); __syncthreads();
    p9_route(p, lds, ch, ch + 1, 1);
  }
}
DEV void build_group_table(const Params& p, LAS int* tab) {
  const int* cnt = (const int*)(p.ws + OFF_CTL);
  const int tid = otid(p.wv);
  if (tid < 32) tab[tid] = cnt[tid];
  __syncthreads();
  if (tid == 0) { int s = 0; for (int e = 0; e < 32; ++e) { tab[32 + e] = s; s += (tab[e] + 255) >> 8; } tab[64] = s; }
  __syncthreads();
}
DEV void p12_combine(const Params& p, const LAS int* tab, float* __restrict__ dst) {
  const bf16_t* __restrict__ ypair = (const bf16_t*)(p.ws + A_YPAIR); const int* __restrict__ paire = (const int*)(p.ws + OFF_PAIRE); const int* __restrict__ pairr = (const int*)(p.ws + OFF_PAIRR); const float* __restrict__ pairg = (const float*)(p.ws + OFF_PAIRG);
  const float* __restrict__ mod = (const float*)(p.ws + OFF_MOD);
  constexpr int RB = 2;
  const int tid = otid(p.wv), wid = tid >> 6, lane = tid & 63;
  const int step = gridDim.x * 8 * RB;
  for (int rb = (blockIdx.x * 8 + wid) * RB; rb < NTOK; rb += 8 * step) {
    unsigned offl = 0u; float gl = 0.f;
    { const int row = rb + (lane >> 3) * step + ((lane >> 2) & 1);
      if (row < NTOK) { const int i = row * 4 + (lane & 3); const int e = paire[i]; offl = (unsigned)(tab[32 + e] * 256 + pairr[i]) * (unsigned)(ACLD * (F8_Y ? 1 : 2)); gl = pairg[i] * (F8_Y ? 1.0f / Y8SCALE : 1.0f); } }
#pragma unroll 2
    for (int it = 0; it < 8; ++it) {
      const int r0 = rb + it * step; if (r0 >= NTOK) break;
      const float* g2 = mod + (size_t)(r0 >> 13) * 6144 + 5120;
      const bf16_t* yr[RB][4]; float gk[RB][4];
#pragma unroll
      for (int j = 0; j < RB; ++j)
#pragma unroll
        for (int k = 0; k < 4; ++k) { const int src = it * 8 + j * 4 + k; yr[j][k] = (const bf16_t*)((const unsigned char*)ypair + (size_t)(unsigned)__builtin_amdgcn_readlane((int)offl, src)); gk[j][k] = __int_as_float(__builtin_amdgcn_readlane(__float_as_int(gl), src)); }
      u32x2 w[RB][4][4]; f32x4 xv[RB][4];
#pragma unroll
      for (int j = 0; j < RB; ++j)
#pragma unroll
        for (int q = 0; q < 4; ++q) { const int col = q * 256 + lane * 4; xv[j][q] = *(const f32x4*)(p.out + (size_t)(r0 + j) * 1024 + col);
#pragma unroll
          for (int k = 0; k < 4; ++k) { if (F8_Y) { w[j][q][k].x = *(const unsigned*)((const unsigned char*)yr[j][k] + col); w[j][q][k].y = 0u; } else w[j][q][k] = *(const u32x2*)(yr[j][k] + col); } }
#pragma unroll
      for (int j = 0; j < RB; ++j)
#pragma unroll
        for (int q = 0; q < 4; ++q) { const int col = q * 256 + lane * 4; f32x4 s = {0.f, 0.f, 0.f, 0.f};
#pragma unroll
          for (int k = 0; k < 4; ++k) { if (F8_Y) { const f32x2 lo = __builtin_amdgcn_cvt_pk_f32_fp8((int)w[j][q][k].x, false), hi = __builtin_amdgcn_cvt_pk_f32_fp8((int)w[j][q][k].x, true); s[0] += gk[j][k] * lo[0]; s[1] += gk[j][k] * lo[1]; s[2] += gk[j][k] * hi[0]; s[3] += gk[j][k] * hi[1]; }
            else { s[0] += gk[j][k] * bflo(w[j][q][k].x); s[1] += gk[j][k] * bfhi(w[j][q][k].x); s[2] += gk[j][k] * bflo(w[j][q][k].y); s[3] += gk[j][k] * bfhi(w[j][q][k].y); } }
          const f32x4 gg = *(const f32x4*)(g2 + col); *(f32x4*)(dst + (size_t)(r0 + j) * 1024 + col) = xv[j][q] + gg * s; }
    }
  }
}

#define XB_TMO      128
#define XB_XCNT(j)  (256  + 64 * (j))
#define XB_XSUB(j)  (1280 + 64 * (j))
#define XB_XGEN(j)  (2304 + 64 * (j))
#define XB_TOP      3328
#define XB_TOPGEN   3392
#define XCD_BAR_WORDS 3456
#define XB_SPIN_CAP (1u << 20)
DEV unsigned xb_ld(unsigned* p)              { return __hip_atomic_load(p, __ATOMIC_RELAXED, __HIP_MEMORY_SCOPE_AGENT); }
DEV unsigned xb_add(unsigned* p, unsigned v) { return __hip_atomic_fetch_add(p, v, __ATOMIC_RELAXED, __HIP_MEMORY_SCOPE_AGENT); }
DEV unsigned xb_xcc_id() { return (unsigned)__builtin_amdgcn_s_getreg((3 << 11) | 20) & 0xFu; }
#define XB_SPIN(cond, bar) do { unsigned _sp = 0; while (cond) { __builtin_amdgcn_s_sleep(1); \
    if ((++_sp & 255u) == 0u) { if (xb_ld(&(bar)[XB_TMO])) break; if (_sp > XB_SPIN_CAP) { atomicAdd(&(bar)[XB_TMO], 1u); break; } } } } while (0)
struct XcdBarrier { unsigned* bar; unsigned x; volatile LAS unsigned* st; int wv; };
DEV XcdBarrier xcd_barrier_post(unsigned* bar, volatile LAS unsigned* st, int wv) {
  XcdBarrier b; b.bar = bar; b.x = xb_xcc_id(); b.st = st; b.wv = wv;
  if (otid(wv) == 0) (void)xb_add(&bar[XB_XCNT(b.x)], 1u);
  return b;
}
DEV void xcd_barrier_complete(unsigned* bar, unsigned x, unsigned& nloc, unsigned& nx) {
  const unsigned G = gridDim.x * gridDim.y * gridDim.z;
  unsigned sum, cnt, mine, sp = 0u;
  for (;;) {
    sum = 0u; cnt = 0u; mine = 0u;
#pragma unroll
    for (unsigned j = 0; j < 16; ++j) { const unsigned c = xb_ld(&bar[XB_XCNT(j)]); sum += c; cnt += (c > 0u) ? 1u : 0u; mine = (j == x) ? c : mine; }
    if (sum == G) break;
    __builtin_amdgcn_s_sleep(1);
    if ((++sp & 255u) == 0u) { if (xb_ld(&bar[XB_TMO])) break; if (sp > XB_SPIN_CAP) { atomicAdd(&bar[XB_TMO], 1u); break; } }
  }
  nloc = mine > 0u ? mine : 1u; nx = cnt > 0u ? cnt : 1u;
}
DEV void xcd_barrier(const XcdBarrier& b) {
  asm volatile("s_waitcnt vmcnt(0)" ::: "memory");
  __syncthreads();
  if (otid(b.wv) == 0) {
    unsigned* bar = b.bar;
    __builtin_amdgcn_s_waitcnt(0);
    unsigned nloc = b.st[0], nx = b.st[1];
    if (nloc == 0u) { xcd_barrier_complete(bar, b.x, nloc, nx); b.st[0] = nloc; b.st[1] = nx; }
    const unsigned old = xb_add(&bar[XB_XSUB(b.x)], 1u);
    const unsigned gen = old / nloc;
    if (old + 1u == (gen + 1u) * nloc) {
      __builtin_amdgcn_fence(__ATOMIC_RELEASE, "agent");
      asm volatile("s_waitcnt vmcnt(0)" ::: "memory");
      const unsigned og = xb_add(&bar[XB_TOP], 1u);
      const unsigned tg = og / nx;
      if (og + 1u == (tg + 1u) * nx) xb_add(&bar[XB_TOPGEN], 1u);
      else XB_SPIN(xb_ld(&bar[XB_TOPGEN]) == tg, bar);
      __builtin_amdgcn_fence(__ATOMIC_ACQUIRE, "agent");
      xb_add(&bar[XB_XGEN(b.x)], 1u);
      asm volatile("s_waitcnt vmcnt(0)" ::: "memory");
    } else {
      XB_SPIN(xb_ld(&bar[XB_XGEN(b.x)]) == gen, bar);
      __builtin_amdgcn_fence(__ATOMIC_ACQUIRE, "agent");
      asm volatile("s_waitcnt vmcnt(0)" ::: "memory");
    }
  }
  __syncthreads();
}
#endif
extern __shared__ __attribute__((aligned(16))) unsigned char smem_raw[];
__global__ void __launch_bounds__(NTHR, 2) mk_fwd(Params p_in) {
#if defined(__HIP_DEVICE_COMPILE__)
  Params p = p_in; p.wv = __builtin_amdgcn_readfirstlane((int)(threadIdx.x >> 6));
  cg::grid_group grid = cg::this_grid();
  LAS unsigned char* lds = (LAS unsigned char*)smem_raw;
  const int G = gridDim.x, c = blockIdx.x;
  const float* mod = (const float*)(p.ws + OFF_MOD);
  volatile LAS unsigned* xst = (volatile LAS unsigned*)(lds + (LDS_BYTES - 64));
  { const int t0_ = otid(p.wv); if (t0_ < 4) xst[t0_] = 0u; }
  __syncthreads();
  const XcdBarrier xb = xcd_barrier_post((unsigned*)(p.ws + OFF_BAR), xst, p.wv);
  if (G == 256) {
    if (c < 128) p0_filters(p, lds, c, 128); else p0_mod(p, lds, c - 128, 128);
  } else { p0_mod(p, lds, c, G); p0_filters(p, lds, c, G); }
  p0_transposes(p, lds);
  xcd_barrier(xb);
  if (p.ws == nullptr) grid.sync();
  p0b_reduce(p, lds);
  xcd_barrier(xb);
  if (G == 256) p1_queue(p, lds, mod);
  else { p1_ctx(p, lds, c, G); rows_norm_mod(p.x, p.norm1_g, mod, 0, 1024, (bf16_t*)(p.ws + A_H), p.wv, c, G); p1_spectrum(p, lds, c, G, true); }
  xcd_barrier(xb);
  { DenseOrder S; S.init(NTOK, INCP, 1024, p.ws + OFF_WINT, G, c); EpiBf16 E{(bf16_t*)(p.ws + A_HCAT), HCLD}; gemm_phase(lds, p.ws + A_H, S, E, p.wv); }
  xcd_barrier(xb);
  p3_hyena_prep(p, lds);
  { DenseOrder S; S.init(NTOK, 768, 256, p.ws + OFF_WUQT, G, c, HCLD); EpiBf16 E{(bf16_t*)(p.ws + A_QRAW), 768}; gemm_phase(lds, (const bf16_t*)(p.ws + A_HCAT) + CQCOL, S, E, p.wv); }
  { DenseOrder S; S.init(NTOK, 1024, 128, p.ws + OFF_WUKVT, G, c, HCLD); EpiBf16 E{(bf16_t*)(p.ws + A_KVRAW), ACLD}; gemm_phase(lds, (const bf16_t*)(p.ws + A_HCAT) + KVCOL, S, E, p.wv); }
  xcd_barrier(xb);
  p5_qkv_final(p);
  p6_conv(p, lds);
  xcd_barrier(xb);
  p7_transpose(p, lds);
  p6_attention(p, lds);
  xcd_barrier(xb);
  { DenseOrder S; S.init(NTOK, 1024, 1024, p.ws + OFF_WOUTT, G, c); EpiResid E{p.x, p.out, mod}; gemm_phase(lds, p.ws + A_YMIX, S, E, p.wv); }
  xcd_barrier(xb);
  p9_router(p, lds, mod);
  xcd_barrier(xb);
  LAS int* tab = (LAS int*)(lds + TAB_OFF);
  build_group_table(p, tab);
  { GroupedOrder<true> S; S.init(2048, F8_G1 ? 512 : 1024, p.ws + OFF_WGUT, tab, (const int*)(p.ws + OFF_ROWTOK), G, c, p.wv); EpiGluT<F8_G1 != 0, F8_G2 != 0> E{(bf16_t*)(p.ws + A_ACT), p.b_gu};
    gemm_phase<decltype(E), decltype(S), F8_G1 != 0>(lds, p.ws + (F8_G1 ? A_H2F8 : A_H2), S, E, p.wv); }
  xcd_barrier(xb);
  { GroupedOrder<false> S; S.init(1024, F8_G2 ? 512 : 1024, p.ws + OFF_WDNT, tab, nullptr, G, c, p.wv, F8_G2 ? ACLD / 2 : ACLD); EpiDownT<F8_G2 != 0, F8_Y != 0> E{(bf16_t*)(p.ws + A_YPAIR), p.b_down};
    gemm_phase<decltype(E), decltype(S), F8_G2 != 0>(lds, p.ws + A_ACT, S, E, p.wv); }
  xcd_barrier(xb);
  p12_combine(p, tab, p.out);
#endif
}

extern "C" void kernel_launch(void* const* d_in, const int* in_sizes, int n_in, void* d_out, int out_size, void* d_ws, size_t ws_size, hipStream_t stream) {
  static int grid_blocks = 0;
  if (!grid_blocks) {
    int dev = 0, cus = 0, per_cu = 0;
    if (n_in != 33 || ws_size < WS_NEED) { fprintf(stderr, "kernel_launch: unexpected n_in %d or ws_size %zu (need %zu)\n", n_in, ws_size, WS_NEED); return; }
    (void)hipGetDevice(&dev);
    (void)hipDeviceGetAttribute(&cus, hipDeviceAttributeMultiprocessorCount, dev);
    if (hipFuncSetAttribute((const void*)mk_fwd, hipFuncAttributeMaxDynamicSharedMemorySize, (int)LDS_BYTES) != hipSuccess) { fprintf(stderr, "kernel_launch: hipFuncSetAttribute failed\n"); return; }
    if (hipOccupancyMaxActiveBlocksPerMultiprocessor(&per_cu, (const void*)mk_fwd, NTHR, LDS_BYTES) != hipSuccess || per_cu < 1) { fprintf(stderr, "kernel_launch: occupancy query failed\n"); return; }
    grid_blocks = cus;
  }
  Params p{};
  const float** pp = (const float**)&p;
  for (int i = 0; i < 33; ++i) pp[i] = (const float*)d_in[i];
  p.out = (float*)d_out; p.ws = (unsigned char*)d_ws;
  (void)hipMemsetAsync(d_ws, 0, ZERO_BYTES, stream);
  void* args[] = {&p};
  hipError_t e = hipLaunchCooperativeKernel((void*)mk_fwd, dim3(grid_blocks), dim3(NTHR), args, LDS_BYTES, stream);
  if (e != hipSuccess) fprintf(stderr, "cooperative launch failed: %s (grid %d)\n", hipGetErrorString(e), grid_blocks);
}
```
